# Optimizing an MI355X kernel written in HIP

```python
import math
import jax, jax.numpy as jnp
from jax import lax
import numpy as np


D_MODEL = 1024
BATCH = 8
SEQ = 4096
DEPTH = 2

CHUNK = 64
N_MIXERS = 2
N_POOL_LAYERS = (DEPTH + N_MIXERS - 1) // N_MIXERS
N_SB_LAYERS = DEPTH // N_MIXERS

POOL_WINDOWS = (2, 4, 8, 16)
N_POOL_GROUPS = len(POOL_WINDOWS)
POOL_GROUP_W = D_MODEL // N_POOL_GROUPS

N_HEADS = 16
HEAD_DIM = D_MODEL // N_HEADS
Q_BLOCK = 128

D_FF = ((8 * D_MODEL // 3 + 255) // 256) * 256

DEEPNORM_ALPHA = (2.0 * DEPTH) ** 0.25
DEEPNORM_BETA = (8.0 * DEPTH) ** -0.25
LN_EPS = 1e-5

kernel_name = "hybrid_pool_stickbreak_deepnorm_trunk"


def _layer_norm(x, g, b):
    xf = x.astype(jnp.float32)
    mu = jnp.mean(xf, axis=-1, keepdims=True)
    var = jnp.mean(jnp.square(xf - mu), axis=-1, keepdims=True)
    y = (xf - mu) * lax.rsqrt(var + LN_EPS) * g.astype(jnp.float32) + b.astype(jnp.float32)
    return y.astype(x.dtype)


def _pool_mixer(x, w_grp, scale):
    B, S, D = x.shape
    xg = x.reshape(B, S, N_POOL_GROUPS, POOL_GROUP_W)
    xf = xg.astype(jnp.float32)
    c = jnp.cumsum(xf, axis=1)
    c = jnp.concatenate([jnp.zeros((B, 1, N_POOL_GROUPS, POOL_GROUP_W), jnp.float32), c], axis=1)
    t = jnp.arange(S)
    pooled = []
    for g, w in enumerate(POOL_WINDOWS):
        cg = c[:, :, g]
        hi = cg[:, 1:]
        lo = jnp.pad(cg, ((0, 0), (w - 1, 0), (0, 0)))[:, :S]
        cnt = jnp.minimum(t + 1, w).astype(jnp.float32)[None, :, None]
        pooled.append((hi - lo) / cnt)
    pooled = jnp.stack(pooled, axis=2)
    mix = (pooled - xf).astype(x.dtype)
    y = jnp.einsum('bsgc,gcd->bsgd', mix, w_grp).reshape(B, S, D)
    return y * scale


def _stick_breaking_attention(x, w_qkv, w_o):
    B, S, D = x.shape
    qkv = jnp.einsum('bsd,de->bse', x, w_qkv).reshape(B, S, 3, N_HEADS, HEAD_DIM)
    q = jnp.transpose(qkv[:, :, 0], (0, 2, 1, 3))
    k = jnp.transpose(qkv[:, :, 1], (0, 2, 1, 3))
    v = jnp.transpose(qkv[:, :, 2], (0, 2, 1, 3))
    inv_sqrt_d = 1.0 / math.sqrt(HEAD_DIM)
    outs = []
    for blk in range(S // Q_BLOCK):
        q0 = blk * Q_BLOCK
        q1 = q0 + Q_BLOCK
        qb = q[:, :, q0:q1]
        kb = k[:, :, :q1]
        vb = v[:, :, :q1]
        z = jnp.einsum('bhqd,bhkd->bhqk', qb, kb).astype(jnp.float32) * inv_sqrt_d
        qpos = (q0 + jnp.arange(Q_BLOCK))[:, None]
        kpos = jnp.arange(q1)[None, :]
        mask = kpos < qpos
        log_beta = jax.nn.log_sigmoid(z)
        log_1mb = jnp.where(mask, jax.nn.log_sigmoid(-z), 0.0)
        suffix = lax.cumsum(log_1mb, axis=3, reverse=True) - log_1mb
        a = jnp.where(mask, jnp.exp(log_beta + suffix), 0.0)
        outs.append(jnp.einsum('bhqk,bhkd->bhqd', a.astype(vb.dtype), vb))
    o = jnp.concatenate(outs, axis=2)
    o = jnp.transpose(o, (0, 2, 1, 3)).reshape(B, S, D)
    return jnp.einsum('bsd,de->bse', o, w_o)


def _swiglu(x, w_gate, w_up, w_down):
    h = jax.nn.silu(jnp.einsum('bsd,df->bsf', x, w_gate)) * jnp.einsum('bsd,df->bsf', x, w_up)
    return jnp.einsum('bsf,fd->bsd', h, w_down)


def setup_inputs(seed: int = 0) -> dict:
    key = jax.random.key(seed)
    ks = jax.random.split(key, 16)
    f32 = jnp.float32
    D, F, C = D_MODEL, D_FF, POOL_GROUP_W
    x = jax.random.normal(ks[0], (BATCH, SEQ, D), f32)
    ln_mix_g = 1.0 + 0.02 * jax.random.normal(ks[1], (DEPTH, D), f32)
    ln_mix_b = 0.02 * jax.random.normal(ks[2], (DEPTH, D), f32)
    ln_ffn_g = 1.0 + 0.02 * jax.random.normal(ks[3], (DEPTH, D), f32)
    ln_ffn_b = 0.02 * jax.random.normal(ks[4], (DEPTH, D), f32)
    pool_w = jax.random.normal(ks[5], (N_POOL_LAYERS, N_POOL_GROUPS, C, C), f32) * (C ** -0.5) * DEEPNORM_BETA
    pool_scale = 1.0 + 0.02 * jax.random.normal(ks[6], (N_POOL_LAYERS, D), f32)
    w_qk = jax.random.normal(ks[7], (N_SB_LAYERS, D, 2 * D), f32) * (D ** -0.5)
    w_v = jax.random.normal(ks[8], (N_SB_LAYERS, D, D), f32) * (D ** -0.5) * DEEPNORM_BETA
    w_qkv = jnp.concatenate([w_qk, w_v], axis=-1)
    w_o = jax.random.normal(ks[9], (N_SB_LAYERS, D, D), f32) * (D ** -0.5) * DEEPNORM_BETA
    w_gate = jax.random.normal(ks[10], (DEPTH, D, F), f32) * (D ** -0.5)
    w_up = jax.random.normal(ks[11], (DEPTH, D, F), f32) * (D ** -0.5) * DEEPNORM_BETA
    w_down = jax.random.normal(ks[12], (DEPTH, F, D), f32) * (F ** -0.5) * DEEPNORM_BETA
    return {"x": x, "ln_mix_g": ln_mix_g, "ln_mix_b": ln_mix_b, "ln_ffn_g": ln_ffn_g, "ln_ffn_b": ln_ffn_b,
            "pool_w": pool_w, "pool_scale": pool_scale, "w_qkv": w_qkv, "w_o": w_o,
            "w_gate": w_gate, "w_up": w_up, "w_down": w_down}


def reference(x, ln_mix_g, ln_mix_b, ln_ffn_g, ln_ffn_b, pool_w, pool_scale, w_qkv, w_o, w_gate, w_up, w_down):
    for i in range(DEPTH):
        j = i // N_MIXERS
        if i % N_MIXERS == 0:
            m = _pool_mixer(x, pool_w[j], pool_scale[j])
        else:
            m = _stick_breaking_attention(x, w_qkv[j], w_o[j])
        x = _layer_norm(DEEPNORM_ALPHA * x + m, ln_mix_g[i], ln_mix_b[i])
        f = _swiglu(x, w_gate[i], w_up[i], w_down[i])
        x = _layer_norm(DEEPNORM_ALPHA * x + f, ln_ffn_g[i], ln_ffn_b[i])
    return x
```

```cpp
#include <hip/hip_runtime.h>
#include <hip/hip_cooperative_groups.h>
#include <cstdio>
#include <cstdint>
namespace cg = cooperative_groups;

#define LAS __attribute__((address_space(3)))
typedef unsigned short bf16_t;
typedef short bf16x8 __attribute__((ext_vector_type(8)));
typedef float f32x4 __attribute__((ext_vector_type(4)));
typedef float f32x2 __attribute__((ext_vector_type(2)));
typedef float f32x16 __attribute__((ext_vector_type(16)));
typedef unsigned u32x4 __attribute__((ext_vector_type(4)));
typedef unsigned u32x2 __attribute__((ext_vector_type(2)));
typedef short v4i16_t __attribute__((ext_vector_type(4)));

constexpr int SEQ = 4096, NB = 8, M = NB * SEQ, D = 1024, FF = 2816, NGU = 2 * FF, NQKV = 3 * D, NH = 16;
constexpr float ALPHA = 1.41421356237309515f;
constexpr float LN_EPS = 1e-5f;
constexpr float QSCALE = 0.125f * 1.4426950408889634f;

constexpr size_t MiB = 1u << 20;
constexpr size_t WS_BAR = 0;
constexpr size_t WS_VEC = 1 * MiB;
constexpr size_t WS_ST = 2 * MiB;
constexpr size_t WS_WPOOL = 8 * MiB, WS_WQKV = 9 * MiB, WS_WO = 15 * MiB, WS_WGU0 = 17 * MiB, WS_WGU1 = 28 * MiB, WS_WD0 = 39 * MiB, WS_WD1 = 45 * MiB;
constexpr size_t WS_XB = 64 * MiB;
constexpr size_t WS_R = 128 * MiB;
constexpr size_t WS_H = WS_R, WS_Q = WS_R, WS_K = WS_R + 64 * MiB, WS_V = WS_R + 128 * MiB, WS_O = WS_R + 192 * MiB, WS_MIX = WS_R + 192 * MiB;
constexpr size_t WS_END = WS_R + 256 * MiB;
constexpr int V_CS_QKV = 0, V_BW_QKV = 3072, V_CS_GU0 = 6144, V_BW_GU0 = V_CS_GU0 + NGU, V_CS_GU1 = V_BW_GU0 + NGU, V_BW_GU1 = V_CS_GU1 + NGU;

constexpr int RING_BYTES = 131072, EPI_OFF = RING_BYTES, EPI_BYTES = 8192, MISC_OFF = EPI_OFF + EPI_BYTES, LDS_BYTES = MISC_OFF + 256;

__device__ __forceinline__ unsigned f2bf(float f) { unsigned u = __builtin_bit_cast(unsigned, f); return (u + 0x7fffu + ((u >> 16) & 1u)) >> 16; }
__device__ __forceinline__ unsigned pk2(float lo, float hi) { return f2bf(lo) | (f2bf(hi) << 16); }
__device__ __forceinline__ float bfround(float f) { return __builtin_bit_cast(float, f2bf(f) << 16); }
__device__ __forceinline__ unsigned cvt_pk_bf16(float lo, float hi) { unsigned r; asm volatile("v_cvt_pk_bf16_f32 %0, %1, %2" : "=v"(r) : "v"(lo), "v"(hi)); return r; }

namespace pg8 {
constexpr int BM = 256, BK = 64, HALF = 128, HTB = HALF * BK * 2, STAGE_BYTES = 8 * HTB, NXCD = 8, WGM = 8;
__host__ __device__ __forceinline__ int lds_byte(int r, int c) { const int st = (r >> 4) * 2 + (c >> 5), rr = r & 15, cc = c & 31, ob = rr * 64 + cc * 2; return st * 1024 + (ob ^ (((ob >> 9) & 1) << 5)); }
__host__ __device__ __forceinline__ void stage_rc(int b, int& R, int& C) { const int st = b / 1024, sb = b % 1024, swz = sb ^ (((sb >> 9) & 1) << 5); R = (st >> 1) * 16 + swz / 64; C = (st & 1) * 32 + (swz % 64) / 2; }
__host__ __device__ __forceinline__ int perm32(int rho) { const int n = rho >> 4, i = rho & 15; return 8 * (i >> 2) + 4 * n + (i & 3); }

struct Unit { int pm, pn; };
struct Gemm { const bf16_t* A; const bf16_t* Bt; int M, N, K, lda, ldb, acol; };

struct StaticOrder {
    int nM, nN, nwg, G, c;
    __device__ void init(int M_, int N_, int G_, int c_) { nM = M_ / BM; nN = N_ / BM; nwg = nM * nN; G = G_; c = c_; }
    __device__ bool next(int i, Unit& u) const {
        const long L = (long)i * G + c; if (L >= nwg) return false;
        int wgid = (int)L; { const int q = nwg / NXCD, r = nwg % NXCD, xcd = wgid % NXCD, off = wgid / NXCD; wgid = (xcd < r ? xcd * (q + 1) : r * (q + 1) + (xcd - r) * q) + off; }
        const int nig = WGM * nN, gid = wgid / nig, fm = gid * WGM, gsz = (nM - fm) < WGM ? (nM - fm) : WGM;
        u.pm = fm + ((wgid % nig) % gsz); u.pn = (wgid % nig) / gsz; return true;
    }
};

__device__ __forceinline__ void row_stats(const float* st, size_t row, float& mu, float& rstd) {
    const f32x4* p = (const f32x4*)(st + row * 8);
    const f32x4 a = p[0], b = p[1];
    const float mean = ((a.x + a.z) + (b.x + b.z)) * 0.25f;
    const float d0 = a.x - mean, d1 = a.z - mean, d2 = b.x - mean, d3 = b.z - mean;
    const float m2 = (a.y + a.w) + (b.y + b.w) + 256.0f * ((d0 * d0 + d1 * d1) + (d2 * d2 + d3 * d3));
    mu = mean; rstd = 1.0f / sqrtf(m2 * (1.0f / 1024.0f) + LN_EPS);
}


struct EpiSwiglu {
    static constexpr bool PERM = true;
    bf16_t* Hout; const float* st; const float* cs; const float* bw;
    __device__ __forceinline__ void operator()(f32x4 (&acc)[2][2][4][2], const Unit& u, int wr, int wc, int fr, int fq, LAS unsigned char*, int, int) const {
        const int tc = u.pn * BM + wc * 32 + 8 * fq, hc = u.pn * HALF + wc * 32 + 8 * fq;
        f32x4 csv[2][2], bwv[2][2];
#pragma unroll
        for (int bj = 0; bj < 2; ++bj)
#pragma unroll
            for (int n = 0; n < 2; ++n) { csv[bj][n] = *(const f32x4*)(cs + tc + bj * HALF + 4 * n); bwv[bj][n] = *(const f32x4*)(bw + tc + bj * HALF + 4 * n); }
#pragma unroll
        for (int ai = 0; ai < 2; ++ai)
#pragma unroll
            for (int m = 0; m < 4; ++m) {
                const size_t row = (size_t)u.pm * BM + ai * HALF + wr * 64 + m * 16 + fr;
                float mu, rs; row_stats(st, row, mu, rs);
                unsigned w[4];
#pragma unroll
                for (int n = 0; n < 2; ++n) {
                    const f32x4 g = (acc[ai][0][m][n] - mu * csv[0][n]) * rs + bwv[0][n];
                    const f32x4 up = (acc[ai][1][m][n] - mu * csv[1][n]) * rs + bwv[1][n];
                    float h[4];
#pragma unroll
                    for (int e = 0; e < 4; ++e) { const float ex = __builtin_amdgcn_exp2f(g[e] * -1.4426950408889634f); h[e] = g[e] * __builtin_amdgcn_rcpf(1.0f + ex) * up[e]; }
                    w[2 * n] = cvt_pk_bf16(h[0], h[1]); w[2 * n + 1] = cvt_pk_bf16(h[2], h[3]);
                }
                *(u32x4*)(Hout + row * FF + hc) = (u32x4){w[0], w[1], w[2], w[3]};
                if (m & 1) asm volatile("" ::: "memory");
            }
    }
};
struct EpiQkv {
    static constexpr bool PERM = true;
    bf16_t* O; size_t stride; const float* st; const float* cs; const float* bw;
    __device__ __forceinline__ void operator()(f32x4 (&acc)[2][2][4][2], const Unit& u, int wr, int wc, int fr, int fq, LAS unsigned char*, int, int) const {
        const int tc = u.pn * BM + wc * 32 + 8 * fq; const int t = u.pn >> 2; const int oc = (u.pn & 3) * BM + wc * 32 + 8 * fq;
        bf16_t* base = O + (size_t)t * stride; const float sc = (t == 0) ? QSCALE : 1.0f;
        f32x4 csv[2][2], bwv[2][2];
#pragma unroll
        for (int bj = 0; bj < 2; ++bj)
#pragma unroll
            for (int n = 0; n < 2; ++n) { csv[bj][n] = *(const f32x4*)(cs + tc + bj * HALF + 4 * n); bwv[bj][n] = *(const f32x4*)(bw + tc + bj * HALF + 4 * n); }
#pragma unroll
        for (int ai = 0; ai < 2; ++ai)
#pragma unroll
            for (int m = 0; m < 4; ++m) {
                const size_t row = (size_t)u.pm * BM + ai * HALF + wr * 64 + m * 16 + fr;
                float mu, rs; row_stats(st, row, mu, rs);
#pragma unroll
                for (int bj = 0; bj < 2; ++bj) {
                    const f32x4 v0 = ((acc[ai][bj][m][0] - mu * csv[bj][0]) * rs + bwv[bj][0]) * sc;
                    const f32x4 v1 = ((acc[ai][bj][m][1] - mu * csv[bj][1]) * rs + bwv[bj][1]) * sc;
                    *(u32x4*)(base + row * D + oc + bj * HALF) = (u32x4){cvt_pk_bf16(v0[0], v0[1]), cvt_pk_bf16(v0[2], v0[3]), cvt_pk_bf16(v1[0], v1[1]), cvt_pk_bf16(v1[2], v1[3])};
                }
                if (m & 1) asm volatile("" ::: "memory");
            }
    }
};
template <int MODE> struct EpiRes {
    static constexpr bool PERM = false;
    const float* base; float* y; bf16_t* yb; const float* stp; float* sto; const float* v0; const float* v1;
    __device__ __forceinline__ void operator()(f32x4 (&acc)[2][2][4][2], const Unit& u, int wr, int wc, int fr, int fq, LAS unsigned char* el, int wid, int lane) const {
        LAS f32x2* P = (LAS f32x2*)el;
        const int col0 = u.pn * BM + wc * 32 + 4 * fq;
        f32x4 ga[2][2], gb[2][2];
#pragma unroll
        for (int bj = 0; bj < 2; ++bj)
#pragma unroll
            for (int n = 0; n < 2; ++n) { const int c = col0 + bj * HALF + n * 16; ga[bj][n] = *(const f32x4*)(v0 + c); if (MODE == 1) gb[bj][n] = *(const f32x4*)(v1 + c) * ALPHA; else gb[bj][n] = (f32x4){0.f, 0.f, 0.f, 0.f}; }
#pragma unroll
        for (int ai = 0; ai < 2; ++ai)
#pragma unroll
            for (int m = 0; m < 4; ++m) {
                const int rl = ai * HALF + wr * 64 + m * 16 + fr; const size_t row = (size_t)u.pm * BM + rl; const size_t off = row * D + col0;
                float mu = 0.f, rs = 0.f; if (MODE == 1) { row_stats(stp, row, mu, rs); rs *= ALPHA; }
                float s = 0.f;
#pragma unroll
                for (int bj = 0; bj < 2; ++bj)
#pragma unroll
                    for (int n = 0; n < 2; ++n) {
                        const f32x4 bs = *(const f32x4*)(base + off + bj * HALF + n * 16); f32x4 v;
                        if (MODE == 0) v = bs * ALPHA + acc[ai][bj][m][n] * ga[bj][n];
                        else v = (bs - mu) * rs * ga[bj][n] + gb[bj][n] + acc[ai][bj][m][n];
                        acc[ai][bj][m][n] = v; s += (v[0] + v[1]) + (v[2] + v[3]);
                        *(f32x4*)(y + off + bj * HALF + n * 16) = v;
                        if (yb) *(u32x2*)(yb + off + bj * HALF + n * 16) = (u32x2){cvt_pk_bf16(v[0], v[1]), cvt_pk_bf16(v[2], v[3])};
                    }
                s += __shfl_xor(s, 16); s += __shfl_xor(s, 32);
                const float mw = s * (1.0f / 64.0f); float q = 0.f;
#pragma unroll
                for (int bj = 0; bj < 2; ++bj)
#pragma unroll
                    for (int n = 0; n < 2; ++n) { const f32x4 d = acc[ai][bj][m][n] - mw; q += (d[0] * d[0] + d[1] * d[1]) + (d[2] * d[2] + d[3] * d[3]); }
                q += __shfl_xor(q, 16); q += __shfl_xor(q, 32);
                if (fq == 0) P[rl * 4 + wc] = (f32x2){mw, q};
                asm volatile("" ::: "memory");
            }
        asm volatile("s_waitcnt lgkmcnt(0)" ::: "memory"); __builtin_amdgcn_s_barrier(); asm volatile("" ::: "memory");
        if (lane < 32) {
            const int row = wid * 32 + lane;
            const f32x2 a = P[row * 4 + 0], b = P[row * 4 + 1], c = P[row * 4 + 2], d = P[row * 4 + 3];
            const float mt = ((a.x + b.x) + (c.x + d.x)) * 0.25f;
            const float da = a.x - mt, db = b.x - mt, dc = c.x - mt, dd = d.x - mt;
            const float m2 = (a.y + b.y) + (c.y + d.y) + 64.0f * ((da * da + db * db) + (dc * dc + dd * dd));
            *(f32x2*)(sto + ((size_t)u.pm * BM + row) * 8 + u.pn * 2) = (f32x2){mt, m2};
        }
        asm volatile("s_waitcnt lgkmcnt(0)" ::: "memory"); __builtin_amdgcn_s_barrier(); asm volatile("" ::: "memory");
    }
};

template <class Epi, class Sched>
__device__ __forceinline__ void gemm_phase(LAS unsigned char* lds, LAS unsigned char* el, const Gemm g, const Sched& S, const Epi& E) {
    int tid = threadIdx.x; asm volatile("" : "+v"(tid));
    const int wid = __builtin_amdgcn_readfirstlane(tid >> 6), lane = tid & 63, wr = wid >> 2, wc = wid & 3, fr = lane & 15, fq = lane >> 4;
    int K = g.K; asm volatile("" : "+s"(K));
    const int nt = K / BK;
    unsigned voffA[2], voffB[2];
#pragma unroll
    for (int i = 0; i < 2; ++i) { int R, C; stage_rc(tid * 16 + i * 8192, R, C); const int Rb = Epi::PERM ? ((R & ~31) + perm32(R & 31)) : R;
        voffA[i] = (unsigned)(R * g.lda + C) * 2u; voffB[i] = (unsigned)(Rb * g.ldb + C) * 2u; }
    const size_t kstep = (size_t)(BK * 2);
    const size_t hstepA = (size_t)HALF * g.lda * 2, hstepB = (size_t)HALF * g.ldb * 2, tstepA = 2 * hstepA, tstepB = 2 * hstepB, cstepA = (size_t)g.acol * 2;
    const unsigned ldsw = (unsigned)wid * 1024u;
    const int aoff = lds_byte(wr * 64 + fr, fq * 8), boff = lds_byte(wc * 32 + fr, fq * 8);
#define PG8_SA(b, h) (((b) * 2 + (h)) * HTB)
#define PG8_SB(b, h) ((4 + (b) * 2 + (h)) * HTB)
#define PG8_STAGE(bufoff, gbase, voff) do { _Pragma("unroll") for (int _i = 0; _i < 2; ++_i) \
        __builtin_amdgcn_global_load_lds((const unsigned*)((const char*)(gbase) + (voff)[_i]), (LAS unsigned*)(lds + (bufoff) + ldsw + _i * 8192), 16, 0, 0); } while (0)
#define PG8_LDA(dst, b, h) do { _Pragma("unroll") for (int m = 0; m < 4; ++m) _Pragma("unroll") for (int k = 0; k < 2; ++k) dst[m][k] = *(const LAS bf16x8*)(lds + PG8_SA(b, h) + aoff + m * 2048 + k * 1024); } while (0)
#define PG8_LDB(dst, b, h) do { _Pragma("unroll") for (int n = 0; n < 2; ++n) _Pragma("unroll") for (int k = 0; k < 2; ++k) dst[n][k] = *(const LAS bf16x8*)(lds + PG8_SB(b, h) + boff + n * 2048 + k * 1024); } while (0)
#define PG8_MMA(ai, bj, At, Bt) do { __builtin_amdgcn_s_setprio(1); _Pragma("unroll") for (int m = 0; m < 4; ++m) _Pragma("unroll") for (int n = 0; n < 2; ++n) _Pragma("unroll") for (int k = 0; k < 2; ++k) \
        acc[ai][bj][m][n] = __builtin_amdgcn_mfma_f32_16x16x32_bf16(Bt[n][k], At[m][k], acc[ai][bj][m][n], 0, 0, 0); __builtin_amdgcn_s_setprio(0); } while (0)
#define PG8_WAIT_V(n) asm volatile("s_waitcnt vmcnt(" #n ")" ::: "memory")
#define PG8_WAIT_L(n) asm volatile("s_waitcnt lgkmcnt(" #n ")" ::: "memory")
#define PG8_BAR __builtin_amdgcn_s_barrier()
#define PG8_SCHED __builtin_amdgcn_sched_barrier(0)
    Unit cur, nxt; int ui = 0;
    if (!S.next(0, cur)) return;
    f32x4 acc[2][2][4][2];
#pragma unroll
    for (int a = 0; a < 2; ++a)
#pragma unroll
        for (int b = 0; b < 2; ++b)
#pragma unroll
            for (int m = 0; m < 4; ++m)
#pragma unroll
                for (int n = 0; n < 2; ++n) acc[a][b][m][n] = (f32x4){0.f, 0.f, 0.f, 0.f};
    bf16x8 At[4][2], B0[2][2], B1[2][2];
    const char* cA = (const char*)g.A + (size_t)cur.pm * tstepA + (size_t)cur.pn * cstepA; const char* cB = (const char*)g.Bt + (size_t)cur.pn * tstepB;
    PG8_STAGE(PG8_SB(0, 0), cB, voffB); PG8_STAGE(PG8_SB(0, 1), cB + hstepB, voffB); PG8_STAGE(PG8_SA(0, 0), cA, voffA); PG8_STAGE(PG8_SA(0, 1), cA + hstepA, voffA);
    if (wr == 1) PG8_BAR;
    PG8_WAIT_V(2); PG8_BAR;
    PG8_STAGE(PG8_SB(1, 0), cB + kstep, voffB); PG8_STAGE(PG8_SA(1, 0), cA + kstep, voffA); PG8_STAGE(PG8_SB(1, 1), cB + hstepB + kstep, voffB);
    PG8_WAIT_V(6); PG8_BAR;
    for (;;) {
        const bool has_next = S.next(ui + 1, nxt);
        const char* nA = has_next ? (const char*)g.A + (size_t)nxt.pm * tstepA + (size_t)nxt.pn * cstepA : cA; const char* nB = has_next ? (const char*)g.Bt + (size_t)nxt.pn * tstepB : cB;
        for (int t = 0; t < nt; t += 2) {
            const bool last = (t == nt - 2);
            const char* a1 = cA + (size_t)(t + 1) * kstep;
            const char* a2 = last ? nA : cA + (size_t)(t + 2) * kstep; const char* b2 = last ? nB : cB + (size_t)(t + 2) * kstep;
            const char* a3 = a2 + kstep; const char* b3 = b2 + kstep;
            PG8_LDB(B0, 0, 0); PG8_LDB(B1, 0, 1); PG8_SCHED; PG8_LDA(At, 0, 0); PG8_STAGE(PG8_SA(1, 1), a1 + hstepA, voffA);
            PG8_WAIT_V(8); PG8_WAIT_L(0); PG8_BAR; PG8_MMA(0, 0, At, B0); PG8_MMA(0, 1, At, B1); PG8_BAR; PG8_SCHED;
            PG8_LDA(At, 0, 1); PG8_STAGE(PG8_SB(0, 0), b2, voffB); PG8_STAGE(PG8_SB(0, 1), b2 + hstepB, voffB); PG8_STAGE(PG8_SA(0, 0), a2, voffA);
            PG8_WAIT_V(8); PG8_WAIT_L(0); PG8_BAR; PG8_MMA(1, 0, At, B0); PG8_MMA(1, 1, At, B1); PG8_BAR; PG8_SCHED;
            PG8_LDB(B0, 1, 0); PG8_LDB(B1, 1, 1); PG8_SCHED; PG8_LDA(At, 1, 0); PG8_STAGE(PG8_SA(0, 1), a2 + hstepA, voffA);
            PG8_WAIT_V(8); PG8_WAIT_L(0); PG8_BAR; PG8_MMA(0, 0, At, B0); PG8_MMA(0, 1, At, B1); PG8_BAR; PG8_SCHED;
            PG8_LDA(At, 1, 1); PG8_STAGE(PG8_SB(1, 0), b3, voffB); PG8_STAGE(PG8_SB(1, 1), b3 + hstepB, voffB); PG8_STAGE(PG8_SA(1, 0), a3, voffA);
            PG8_WAIT_V(8); PG8_WAIT_L(0); PG8_BAR; PG8_MMA(1, 0, At, B0); PG8_MMA(1, 1, At, B1); PG8_BAR; PG8_SCHED;
        }
        if (wr == 0) PG8_BAR;
        { Unit eu = cur; int efr = fr, efq = fq, elane = lane;
          asm volatile("" : "+s"(eu.pm), "+s"(eu.pn), "+v"(efr), "+v"(efq), "+v"(elane));
          E(acc, eu, wr, wc, efr, efq, el, wid, elane); }
        if (!has_next) break;
#pragma unroll
        for (int a = 0; a < 2; ++a)
#pragma unroll
            for (int b = 0; b < 2; ++b)
#pragma unroll
                for (int m = 0; m < 4; ++m)
#pragma unroll
                    for (int n = 0; n < 2; ++n) acc[a][b][m][n] = (f32x4){0.f, 0.f, 0.f, 0.f};
        cur = nxt; cA = nA; cB = nB; ++ui;
        if (wr == 1) PG8_BAR;
    }
    PG8_WAIT_V(0);
    PG8_BAR;
#undef PG8_SA
#undef PG8_SB
#undef PG8_STAGE
#undef PG8_LDA
#undef PG8_LDB
#undef PG8_MMA
#undef PG8_WAIT_V
#undef PG8_WAIT_L
#undef PG8_BAR
#undef PG8_SCHED
}
}

__device__ __forceinline__ int crow(int r, int hi) { return (r & 3) + 8 * (r >> 2) + 4 * hi; }
__device__ __forceinline__ void attn_phase(LAS unsigned char* lds, const bf16_t* Q, const bf16_t* Kp, const bf16_t* Vp, bf16_t* O, int blk, int G) {
    int tid = threadIdx.x; asm volatile("" : "+v"(tid));
    const int lane = tid & 63, r32 = lane & 31, hi = lane >> 5;
    const int wid = __builtin_amdgcn_readfirstlane(tid >> 6);
    LAS unsigned char* vbuf = lds + wid * 8192;
    LAS bf16_t* obuf = (LAS bf16_t*)(vbuf + 4096);
    LAS unsigned char* vrd = vbuf + ((lane >> 4) & 1) * 32 + (lane & 3) * 8 + (4 * hi + ((lane & 15) >> 2)) * 64;
    LAS bf16x8* vw = (LAS bf16x8*)(vbuf + (lane & 1) * 2048 + (lane >> 1) * 64);
    for (int u = blk; u < (NB * NH * SEQ) / 256; u += G) {
        const int bh = u >> 4, qblk = ((u & 15) << 3) + wid;
        const int b = bh >> 4, h = bh & 15;
        const size_t rowb = (size_t)b * SEQ;
        const bf16_t* qp = Q + (rowb + (size_t)qblk * 32 + r32) * D + h * 64 + hi * 32;
        bf16x8 qf[4];
#pragma unroll
        for (int d0 = 0; d0 < 4; ++d0) qf[d0] = *(const bf16x8*)(qp + d0 * 8);
        const bf16_t* kp = Kp + (rowb + r32) * D + h * 64 + hi * 32;
        const bf16_t* vp = Vp + (rowb + (lane >> 1)) * D + h * 64 + (lane & 1) * 32;
        bf16x8 kf[4], vr[4];
#pragma unroll
        for (int d0 = 0; d0 < 4; ++d0) { kf[d0] = *(const bf16x8*)(kp + (size_t)qblk * 32 * D + d0 * 8); vr[d0] = *(const bf16x8*)(vp + (size_t)qblk * 32 * D + d0 * 8); }
        f32x16 o0, o1;
#pragma unroll
        for (int r = 0; r < 16; ++r) { o0[r] = 0.f; o1[r] = 0.f; }
        float carry = 1.0f;
        for (int kt = qblk; kt >= 0; --kt) {
#pragma unroll
            for (int c = 0; c < 4; ++c) vw[c] = vr[c];
            f32x16 s;
#pragma unroll
            for (int r = 0; r < 16; ++r) s[r] = 0.f;
#pragma unroll
            for (int d0 = 0; d0 < 4; ++d0) s = __builtin_amdgcn_mfma_f32_32x32x16_bf16(kf[d0], qf[d0], s, 0, 0, 0);
            if (kt > 0) {
#pragma unroll
                for (int d0 = 0; d0 < 4; ++d0) { kf[d0] = *(const bf16x8*)(kp + (size_t)(kt - 1) * 32 * D + d0 * 8); vr[d0] = *(const bf16x8*)(vp + (size_t)(kt - 1) * 32 * D + d0 * 8); }
            }
            const bool diag = (kt == qblk);
            float e[16], om[16];
#pragma unroll
            for (int r = 0; r < 16; ++r) {
                float ev = __builtin_amdgcn_exp2f(fminf(s[r], 126.0f));
                if (diag && crow(r, hi) >= r32) ev = 0.f;
                e[r] = ev; om[r] = __builtin_amdgcn_rcpf(1.0f + ev);
            }
            float p32[4], p321[4], gp[4], oth[4];
#pragma unroll
            for (int g = 0; g < 4; ++g) { p32[g] = om[4 * g + 3] * om[4 * g + 2]; p321[g] = p32[g] * om[4 * g + 1]; gp[g] = p321[g] * om[4 * g]; }
#pragma unroll
            for (int g = 0; g < 4; ++g) {
                const unsigned own = __float_as_uint(gp[g]);
                auto rr = __builtin_amdgcn_permlane32_swap(own, own, false, false);
                oth[g] = __uint_as_float(rr[0] != own ? rr[0] : rr[1]);
            }
            float E[4];
            E[3] = carry * (hi ? 1.0f : oth[3]);
            E[2] = E[3] * (gp[3] * (hi ? oth[3] : oth[2]));
            E[1] = E[2] * (gp[2] * (hi ? oth[2] : oth[1]));
            E[0] = E[1] * (gp[1] * (hi ? oth[1] : oth[0]));
            carry = E[0] * (gp[0] * (hi ? oth[0] : 1.0f));
            float a[16];
#pragma unroll
            for (int g = 0; g < 4; ++g) {
                a[4 * g + 3] = e[4 * g + 3] * om[4 * g + 3] * E[g];
                a[4 * g + 2] = e[4 * g + 2] * om[4 * g + 2] * (E[g] * om[4 * g + 3]);
                a[4 * g + 1] = e[4 * g + 1] * om[4 * g + 1] * (E[g] * p32[g]);
                a[4 * g + 0] = e[4 * g + 0] * om[4 * g + 0] * (E[g] * p321[g]);
            }
            const u32x4 pw0 = {cvt_pk_bf16(a[0], a[1]), cvt_pk_bf16(a[2], a[3]), cvt_pk_bf16(a[4], a[5]), cvt_pk_bf16(a[6], a[7])};
            const u32x4 pw1 = {cvt_pk_bf16(a[8], a[9]), cvt_pk_bf16(a[10], a[11]), cvt_pk_bf16(a[12], a[13]), cvt_pk_bf16(a[14], a[15])};
            const bf16x8 pa0 = __builtin_bit_cast(bf16x8, pw0), pa1 = __builtin_bit_cast(bf16x8, pw1);
#pragma unroll
            for (int dblk = 0; dblk < 2; ++dblk) {
                const v4i16_t l0 = __builtin_amdgcn_ds_read_tr16_b64_v4i16((LAS v4i16_t*)(vrd + dblk * 2048));
                const v4i16_t h0 = __builtin_amdgcn_ds_read_tr16_b64_v4i16((LAS v4i16_t*)(vrd + dblk * 2048 + 512));
                const v4i16_t l1 = __builtin_amdgcn_ds_read_tr16_b64_v4i16((LAS v4i16_t*)(vrd + dblk * 2048 + 1024));
                const v4i16_t h1 = __builtin_amdgcn_ds_read_tr16_b64_v4i16((LAS v4i16_t*)(vrd + dblk * 2048 + 1536));
                const bf16x8 vf0 = {l0[0], l0[1], l0[2], l0[3], h0[0], h0[1], h0[2], h0[3]};
                const bf16x8 vf1 = {l1[0], l1[1], l1[2], l1[3], h1[0], h1[1], h1[2], h1[3]};
                if (dblk == 0) { o0 = __builtin_amdgcn_mfma_f32_32x32x16_bf16(pa0, vf0, o0, 0, 0, 0); o0 = __builtin_amdgcn_mfma_f32_32x32x16_bf16(pa1, vf1, o0, 0, 0, 0); }
                else           { o1 = __builtin_amdgcn_mfma_f32_32x32x16_bf16(pa0, vf0, o1, 0, 0, 0); o1 = __builtin_amdgcn_mfma_f32_32x32x16_bf16(pa1, vf1, o1, 0, 0, 0); }
            }
            if (!__any(carry >= 1.17549435e-38f)) break;
        }
#pragma unroll
        for (int r = 0; r < 16; ++r) { const int orow = crow(r, hi); obuf[orow * 64 + r32] = (bf16_t)f2bf(o0[r]); obuf[orow * 64 + 32 + r32] = (bf16_t)f2bf(o1[r]); }
        bf16_t* Ow = O + (rowb + (size_t)qblk * 32) * D + h * 64;
#pragma unroll
        for (int i = 0; i < 4; ++i) { const int row = i * 8 + (lane >> 3), ch = lane & 7; const u32x4 v = *(const LAS u32x4*)(obuf + row * 64 + ch * 8); *(u32x4*)(Ow + (size_t)row * D + ch * 8) = v; }
    }
}

template <int RMAP>
__device__ __forceinline__ void transpose_item(const float* W, int K, int N, bf16_t* WT, int row_off, const float* gk, LAS float* scr, int item, int lane) {
    const int nblk = N / 32, kb = item / nblk, nb = item % nblk, k0 = 64 * kb, n0 = 32 * nb;
#pragma unroll 8
    for (int i = 0; i < 32; ++i) { const int kk = 2 * i + (lane >> 5); float w = W[(size_t)(k0 + kk) * N + n0 + (lane & 31)]; if (gk) w *= gk[k0 + kk]; scr[kk * 33 + (lane & 31)] = w; }
    asm volatile("s_waitcnt lgkmcnt(0)" ::: "memory");
    const int c = lane & 7;
#pragma unroll
    for (int j = 0; j < 4; ++j) { const int n = (lane >> 3) + 8 * j; const LAS float* s = scr + (8 * c) * 33 + n;
        u32x4 o; o.x = pk2(s[0 * 33], s[1 * 33]); o.y = pk2(s[2 * 33], s[3 * 33]); o.z = pk2(s[4 * 33], s[5 * 33]); o.w = pk2(s[6 * 33], s[7 * 33]);
        const int nn = n0 + n; const int orow = RMAP ? ((nn >> 7) * 256 + (nn & 127) + row_off) : (row_off + nn);
        *(u32x4*)(WT + (size_t)orow * K + k0 + 8 * c) = o; }
    asm volatile("s_waitcnt lgkmcnt(0)" ::: "memory");
}
template <int RMAP>
__device__ __forceinline__ void csbw_item(const float* W, int N, const float* g, const float* b, float* cs, float* bw, int row_off, int item, int lane) {
    const int n = item * 32 + (lane & 31), kh = lane >> 5;
    float c = 0.f, w2 = 0.f;
#pragma unroll 8
    for (int k = kh; k < D; k += 2) { const float w = W[(size_t)k * N + n]; c += bfround(g[k] * w); w2 += b[k] * w; }
    c += __shfl_xor(c, 32); w2 += __shfl_xor(w2, 32);
    if (kh == 0) { const int orow = RMAP ? ((n >> 7) * 256 + (n & 127) + row_off) : (row_off + n); cs[orow] = c; bw[orow] = w2; }
}
__device__ __forceinline__ void mix_run(const float* x, bf16_t* mix, int run, int lane) {
    const int t0 = (run & 255) * 16; const size_t row0 = (size_t)run * 16;
    const float* xr = x + row0 * D + 4 * lane;
    f32x4 S[4];
#pragma unroll
    for (int j = 0; j < 4; ++j) { const int w = 2 << j; f32x4 s = {0.f, 0.f, 0.f, 0.f};
#pragma unroll
        for (int i = 1; i < w; ++i) if (t0 - i >= 0) s += *(const f32x4*)(xr - (ptrdiff_t)i * D + 256 * j);
        S[j] = s; }
#pragma unroll 4
    for (int tt = 0; tt < 16; ++tt) {
        const int t = t0 + tt;
#pragma unroll
        for (int j = 0; j < 4; ++j) { const int w = 2 << j;
            const f32x4 xv = *(const f32x4*)(xr + (ptrdiff_t)tt * D + 256 * j);
            S[j] += xv;
            const int cnt = (t + 1 < w) ? (t + 1) : w; const float inv = 1.0f / (float)cnt;
            const f32x4 mx = S[j] * inv - xv;
            *(u32x2*)(mix + (row0 + tt) * D + 256 * j + 4 * lane) = (u32x2){pk2(mx[0], mx[1]), pk2(mx[2], mx[3])};
            if (t - w + 1 >= 0) S[j] -= *(const f32x4*)(xr + (ptrdiff_t)(tt - w + 1) * D + 256 * j);
        }
    }
}

#define XB_TMO      128
#define XB_XCNT(j)  (256  + 64 * (j))
#define XB_XSUB(j)  (1280 + 64 * (j))
#define XB_XGEN(j)  (2304 + 64 * (j))
#define XB_TOP      3328
#define XB_TOPGEN   3392
#define XCD_BAR_WORDS 3456
#define XB_SPIN_CAP (1u << 22)
__device__ __forceinline__ unsigned xb_ld(unsigned* p)              { return __hip_atomic_load(p, __ATOMIC_RELAXED, __HIP_MEMORY_SCOPE_AGENT); }
__device__ __forceinline__ unsigned xb_add(unsigned* p, unsigned v) { return __hip_atomic_fetch_add(p, v, __ATOMIC_RELAXED, __HIP_MEMORY_SCOPE_AGENT); }
__device__ __forceinline__ unsigned xb_xcc_id() { return (unsigned)__builtin_amdgcn_s_getreg((3 << 11) | 20) & 0xFu; }
#define XB_SPIN(cond, bar) do { unsigned _sp = 0; while (cond) { __builtin_amdgcn_s_sleep(1); \
    if ((++_sp & 255u) == 0u) { if (xb_ld(&(bar)[XB_TMO])) break; if (_sp > XB_SPIN_CAP) { atomicAdd(&(bar)[XB_TMO], 1u); break; } } } } while (0)
struct XcdBarrier { unsigned* bar; unsigned x; volatile LAS unsigned* st; };
__device__ __forceinline__ XcdBarrier xcd_barrier_post(unsigned* bar, volatile LAS unsigned* st) {
    XcdBarrier b; b.bar = bar; b.x = xb_xcc_id(); b.st = st;
    if (threadIdx.x == 0) (void)xb_add(&bar[XB_XCNT(b.x)], 1u);
    return b;
}
__device__ __forceinline__ void xcd_barrier_complete(unsigned* bar, unsigned x, unsigned& nloc, unsigned& nx) {
    const unsigned G = gridDim.x * gridDim.y * gridDim.z;
    unsigned sum, cnt, mine, sp = 0u;
    for (;;) {
        sum = 0u; cnt = 0u; mine = 0u;
#pragma unroll
        for (unsigned j = 0; j < 16; ++j) { const unsigned c = xb_ld(&bar[XB_XCNT(j)]); sum += c; cnt += (c > 0u) ? 1u : 0u; mine = (j == x) ? c : mine; }
        if (sum == G) break;
        __builtin_amdgcn_s_sleep(1);
        if ((++sp & 255u) == 0u) { if (xb_ld(&bar[XB_TMO])) break; if (sp > XB_SPIN_CAP) { atomicAdd(&bar[XB_TMO], 1u); break; } }
    }
    nloc = mine > 0u ? mine : 1u; nx = cnt > 0u ? cnt : 1u;
}
__device__ __forceinline__ void xcd_barrier(const XcdBarrier& b) {
    asm volatile("s_waitcnt vmcnt(0)" ::: "memory");
    __syncthreads();
    if (threadIdx.x == 0) {
        unsigned* bar = b.bar;
        __builtin_amdgcn_s_waitcnt(0);
        unsigned nloc = b.st[0], nx = b.st[1];
        if (nloc == 0u) { xcd_barrier_complete(bar, b.x, nloc, nx); b.st[0] = nloc; b.st[1] = nx; }
        const unsigned old = xb_add(&bar[XB_XSUB(b.x)], 1u);
        const unsigned gen = old / nloc;
        if (old + 1u == (gen + 1u) * nloc) {
            __builtin_amdgcn_fence(__ATOMIC_RELEASE, "agent");
            asm volatile("s_waitcnt vmcnt(0)" ::: "memory");
            const unsigned og = xb_add(&bar[XB_TOP], 1u);
            const unsigned tg = og / nx;
            if (og + 1u == (tg + 1u) * nx) xb_add(&bar[XB_TOPGEN], 1u);
            else XB_SPIN(xb_ld(&bar[XB_TOPGEN]) == tg, bar);
            __builtin_amdgcn_fence(__ATOMIC_ACQUIRE, "agent");
            xb_add(&bar[XB_XGEN(b.x)], 1u);
            asm volatile("s_waitcnt vmcnt(0)" ::: "memory");
        } else {
            XB_SPIN(xb_ld(&bar[XB_XGEN(b.x)]) == gen, bar);
            __builtin_amdgcn_fence(__ATOMIC_ACQUIRE, "agent");
            asm volatile("s_waitcnt vmcnt(0)" ::: "memory");
        }
    }
    __syncthreads();
}

#ifndef USE_CG_SYNC
#define USE_CG_SYNC 1
#endif

struct Args { const float* in[12]; float* out; unsigned char* ws; };
__global__ void __launch_bounds__(512, 2) fwd_megakernel(Args args) {
    extern __shared__ __attribute__((aligned(16))) unsigned char lds_raw[];
    LAS unsigned char* lds = (LAS unsigned char*)lds_raw;
    LAS unsigned char* el = lds + EPI_OFF;
    volatile LAS unsigned* MISC = (volatile LAS unsigned*)(lds + MISC_OFF);
    const int tid = threadIdx.x, wave = __builtin_amdgcn_readfirstlane(tid >> 6);
    const int G = gridDim.x, blk = blockIdx.x;
    cg::grid_group grid = cg::this_grid();
    unsigned char* ws = args.ws;
    const float* x = args.in[0]; const float* ln_mix_g = args.in[1]; const float* ln_mix_b = args.in[2]; const float* ln_ffn_g = args.in[3]; const float* ln_ffn_b = args.in[4];
    const float* pool_w = args.in[5]; const float* pool_scale = args.in[6]; const float* w_qkv = args.in[7]; const float* w_o = args.in[8];
    const float* w_gate = args.in[9]; const float* w_up = args.in[10]; const float* w_down = args.in[11];
    float* Y = args.out;
    float* vec = (float*)(ws + WS_VEC);
    float* ST1 = (float*)(ws + WS_ST), *ST2 = (float*)(ws + WS_ST + 1 * MiB), *ST3 = (float*)(ws + WS_ST + 2 * MiB), *ST4 = (float*)(ws + WS_ST + 3 * MiB);
    bf16_t* WPOOL = (bf16_t*)(ws + WS_WPOOL), *WQKV = (bf16_t*)(ws + WS_WQKV), *WO = (bf16_t*)(ws + WS_WO), *WGU0 = (bf16_t*)(ws + WS_WGU0), *WGU1 = (bf16_t*)(ws + WS_WGU1), *WD0 = (bf16_t*)(ws + WS_WD0), *WD1 = (bf16_t*)(ws + WS_WD1);
    bf16_t* XB = (bf16_t*)(ws + WS_XB), *HB = (bf16_t*)(ws + WS_H), *QB = (bf16_t*)(ws + WS_Q), *KB = (bf16_t*)(ws + WS_K), *VB = (bf16_t*)(ws + WS_V), *OB = (bf16_t*)(ws + WS_O), *MIX = (bf16_t*)(ws + WS_MIX);

    if (tid < 64) MISC[tid] = 0u;
    __syncthreads();
#if USE_CG_SYNC
#define GRID_BAR() grid.sync()
#else
    XcdBarrier bar = xcd_barrier_post((unsigned*)(ws + WS_BAR), MISC + 8);
#define GRID_BAR() xcd_barrier(bar)
#endif

    {
        int lane = tid & 63; asm volatile("" : "+v"(lane));
        const int gw = blk * 8 + wave, NGW = G * 8;
        for (int run = gw; run < M / 16; run += NGW) mix_run(x, MIX, run, lane);
        LAS float* scr = (LAS float*)(lds + wave * 16384);
        constexpr int I_POOL = 4 * 4 * 8, I_QKV = 16 * 96, I_WO = 16 * 32, I_G = 16 * 88, I_D = 44 * 32;
        constexpr int NITEMS = I_POOL + I_QKV + I_WO + 4 * I_G + 2 * I_D;
        for (int it = gw; it < NITEMS; it += NGW) {
            int r = it;
            if (r < I_POOL) { const int g = r >> 5; transpose_item<0>(pool_w + (size_t)g * 65536, 256, 256, WPOOL, g * 256, nullptr, scr, r & 31, lane); continue; } r -= I_POOL;
            if (r < I_QKV) { transpose_item<0>(w_qkv, D, NQKV, WQKV, 0, ln_ffn_g, scr, r, lane); continue; } r -= I_QKV;
            if (r < I_WO) { transpose_item<0>(w_o, D, D, WO, 0, nullptr, scr, r, lane); continue; } r -= I_WO;
            if (r < I_G) { transpose_item<1>(w_gate, D, FF, WGU0, 0, ln_mix_g, scr, r, lane); continue; } r -= I_G;
            if (r < I_G) { transpose_item<1>(w_up, D, FF, WGU0, 128, ln_mix_g, scr, r, lane); continue; } r -= I_G;
            if (r < I_G) { transpose_item<1>(w_gate + (size_t)D * FF, D, FF, WGU1, 0, ln_mix_g + D, scr, r, lane); continue; } r -= I_G;
            if (r < I_G) { transpose_item<1>(w_up + (size_t)D * FF, D, FF, WGU1, 128, ln_mix_g + D, scr, r, lane); continue; } r -= I_G;
            if (r < I_D) { transpose_item<0>(w_down, FF, D, WD0, 0, nullptr, scr, r, lane); continue; } r -= I_D;
            transpose_item<0>(w_down + (size_t)FF * D, FF, D, WD1, 0, nullptr, scr, r, lane);
        }
        constexpr int C_QKV = NQKV / 32, C_G = FF / 32;
        for (int it = gw; it < C_QKV + 4 * C_G; it += NGW) {
            int r = it;
            if (r < C_QKV) { csbw_item<0>(w_qkv, NQKV, ln_ffn_g, ln_ffn_b, vec + V_CS_QKV, vec + V_BW_QKV, 0, r, lane); continue; } r -= C_QKV;
            if (r < C_G) { csbw_item<1>(w_gate, FF, ln_mix_g, ln_mix_b, vec + V_CS_GU0, vec + V_BW_GU0, 0, r, lane); continue; } r -= C_G;
            if (r < C_G) { csbw_item<1>(w_up, FF, ln_mix_g, ln_mix_b, vec + V_CS_GU0, vec + V_BW_GU0, 128, r, lane); continue; } r -= C_G;
            if (r < C_G) { csbw_item<1>(w_gate + (size_t)D * FF, FF, ln_mix_g + D, ln_mix_b + D, vec + V_CS_GU1, vec + V_BW_GU1, 0, r, lane); continue; } r -= C_G;
            csbw_item<1>(w_up + (size_t)D * FF, FF, ln_mix_g + D, ln_mix_b + D, vec + V_CS_GU1, vec + V_BW_GU1, 128, r, lane);
        }
    }
    GRID_BAR();
    pg8::StaticOrder S;
    { pg8::Gemm g{MIX, WPOOL, M, D, 256, D, 256, 256}; S.init(M, D, G, blk);
      pg8::EpiRes<0> E{x, Y, XB, nullptr, ST1, pool_scale, nullptr};
      pg8::gemm_phase(lds, el, g, S, E); }
    GRID_BAR();
    { pg8::Gemm g{XB, WGU0, M, NGU, D, D, D, 0}; S.init(M, NGU, G, blk);
      pg8::EpiSwiglu E{HB, ST1, vec + V_CS_GU0, vec + V_BW_GU0};
      pg8::gemm_phase(lds, el, g, S, E); }
    GRID_BAR();
    { pg8::Gemm g{HB, WD0, M, D, FF, FF, FF, 0}; S.init(M, D, G, blk);
      pg8::EpiRes<1> E{Y, Y, XB, ST1, ST2, ln_mix_g, ln_mix_b};
      pg8::gemm_phase(lds, el, g, S, E); }
    GRID_BAR();
    { pg8::Gemm g{XB, WQKV, M, NQKV, D, D, D, 0}; S.init(M, NQKV, G, blk);
      pg8::EpiQkv E{QB, (size_t)M * D, ST2, vec + V_CS_QKV, vec + V_BW_QKV};
      pg8::gemm_phase(lds, el, g, S, E); }
    GRID_BAR();
    attn_phase(lds, QB, KB, VB, OB, blk, G);
    GRID_BAR();
    { pg8::Gemm g{OB, WO, M, D, D, D, D, 0}; S.init(M, D, G, blk);
      pg8::EpiRes<1> E{Y, Y, XB, ST2, ST3, ln_ffn_g, ln_ffn_b};
      pg8::gemm_phase(lds, el, g, S, E); }
    GRID_BAR();
    { pg8::Gemm g{XB, WGU1, M, NGU, D, D, D, 0}; S.init(M, NGU, G, blk);
      pg8::EpiSwiglu E{HB, ST3, vec + V_CS_GU1, vec + V_BW_GU1};
      pg8::gemm_phase(lds, el, g, S, E); }
    GRID_BAR();
    { pg8::Gemm g{HB, WD1, M, D, FF, FF, FF, 0}; S.init(M, D, G, blk);
      pg8::EpiRes<1> E{Y, Y, nullptr, ST3, ST4, ln_mix_g + D, ln_mix_b + D};
      pg8::gemm_phase(lds, el, g, S, E); }
    GRID_BAR();
    {
        int lane = tid & 63; asm volatile("" : "+v"(lane));
        const int gw = blk * 8 + wave, NGW = G * 8;
        const float* gg = ln_ffn_g + D; const float* bb = ln_ffn_b + D;
        f32x4 gv[4], bv[4];
#pragma unroll
        for (int j = 0; j < 4; ++j) { gv[j] = *(const f32x4*)(gg + 256 * j + 4 * lane); bv[j] = *(const f32x4*)(bb + 256 * j + 4 * lane); }
        for (int row = gw; row < M; row += NGW) {
            float mu, rs; pg8::row_stats(ST4, (size_t)row, mu, rs);
            float* yr = Y + (size_t)row * D + 4 * lane;
#pragma unroll
            for (int j = 0; j < 4; ++j) { const f32x4 v = *(const f32x4*)(yr + 256 * j); *(f32x4*)(yr + 256 * j) = (v - mu) * rs * gv[j] + bv[j]; }
        }
    }
}

extern "C" void kernel_launch(void* const* d_in, const int* in_sizes, int n_in, void* d_out, int out_size, void* d_ws, size_t ws_size, hipStream_t stream) {
    static int grid = 0;
    if (grid == 0) {
        if (n_in != 12 || in_sizes[0] != M * D || out_size != M * D || ws_size < WS_END) { fprintf(stderr, "kernel_launch: unexpected shapes (n_in %d, in0 %d, out %d, ws %zu)\n", n_in, n_in > 0 ? in_sizes[0] : -1, out_size, ws_size); grid = -1; return; }
        int dev = 0, cus = 0, per_cu = 0;
        if (hipGetDevice(&dev) != hipSuccess || hipDeviceGetAttribute(&cus, hipDeviceAttributeMultiprocessorCount, dev) != hipSuccess) { grid = -1; return; }
        if (hipFuncSetAttribute((const void*)fwd_megakernel, hipFuncAttributeMaxDynamicSharedMemorySize, LDS_BYTES) != hipSuccess) { fprintf(stderr, "kernel_launch: hipFuncSetAttribute failed\n"); grid = -1; return; }
        if (hipOccupancyMaxActiveBlocksPerMultiprocessor(&per_cu, (const void*)fwd_megakernel, 512, LDS_BYTES) != hipSuccess || per_cu < 1) { fprintf(stderr, "kernel_launch: occupancy query gave %d\n", per_cu); per_cu = 1; }
        (void)hipGetLastError();
        grid = cus * per_cu; if (grid > 256) grid = 256;
    }
    if (grid < 0) return;
    (void)hipMemsetAsync((char*)d_ws + WS_BAR, 0, XCD_BAR_WORDS * 4, stream);
    Args a{};
    for (int i = 0; i < 12; ++i) a.in[i] = (const float*)d_in[i];
    a.out = (float*)d_out; a.ws = (unsigned char*)d_ws;
    void* kargs[] = {&a};
    hipError_t e = hipLaunchCooperativeKernel((const void*)fwd_megakernel, dim3(grid), dim3(512), kargs, LDS_BYTES, stream);
    if (e != hipSuccess) fprintf(stderr, "kernel_launch: cooperative launch failed: %s (grid %d)\n", hipGetErrorString(e), grid);
}
```

```cpp
#include <hip/hip_runtime.h>
#include <hip/hip_cooperative_groups.h>
#include <cstdio>
#include <cstdint>
namespace cg = cooperative_groups;

#define LAS __attribute__((address_space(3)))
typedef unsigned short bf16_t;
typedef short bf16x8 __attribute__((ext_vector_type(8)));
typedef float f32x4 __attribute__((ext_vector_type(4)));
typedef float f32x2 __attribute__((ext_vector_type(2)));
typedef float f32x16 __attribute__((ext_vector_type(16)));
typedef unsigned u32x4 __attribute__((ext_vector_type(4)));
typedef unsigned u32x2 __attribute__((ext_vector_type(2)));
typedef short v4i16_t __attribute__((ext_vector_type(4)));

constexpr int SEQ = 4096, NB = 8, M = NB * SEQ, D = 1024, FF = 2816, NGU = 2 * FF, NQKV = 3 * D, NH = 16;
constexpr float ALPHA = 1.41421356237309515f;
constexpr float LN_EPS = 1e-5f;
constexpr float QSCALE = 0.125f * 1.4426950408889634f;

constexpr size_t MiB = 1u << 20;
constexpr size_t WS_BAR = 0;
constexpr size_t WS_VEC = 1 * MiB;
constexpr size_t WS_ST = 2 * MiB;
constexpr size_t WS_WPOOL = 8 * MiB, WS_WQKV = 9 * MiB, WS_WO = 15 * MiB, WS_WGU0 = 17 * MiB, WS_WGU1 = 28 * MiB, WS_WD0 = 39 * MiB, WS_WD1 = 45 * MiB;
constexpr size_t WS_XB = 64 * MiB;
constexpr size_t WS_R = 128 * MiB;
constexpr size_t WS_H = WS_R, WS_Q = WS_R, WS_K = WS_R + 64 * MiB, WS_V = WS_R + 128 * MiB, WS_O = WS_R + 192 * MiB, WS_MIX = WS_R + 192 * MiB;
constexpr size_t WS_END = WS_R + 256 * MiB;
constexpr int V_CS_QKV = 0, V_BW_QKV = 3072, V_CS_GU0 = 6144, V_BW_GU0 = V_CS_GU0 + NGU, V_CS_GU1 = V_BW_GU0 + NGU, V_BW_GU1 = V_CS_GU1 + NGU;
constexpr int VEC_TOT = V_BW_GU1 + NGU;
constexpr size_t WS_VPART = 6 * MiB;

constexpr int RING_BYTES = 131072, EPI_OFF = RING_BYTES, EPI_BYTES = 8192, MISC_OFF = EPI_OFF + EPI_BYTES, LDS_BYTES = MISC_OFF + 256;

__device__ __forceinline__ unsigned f2bf(float f) { unsigned u = __builtin_bit_cast(unsigned, f); return (u + 0x7fffu + ((u >> 16) & 1u)) >> 16; }
__device__ __forceinline__ unsigned pk2(float lo, float hi) { return f2bf(lo) | (f2bf(hi) << 16); }
__device__ __forceinline__ float bfround(float f) { return __builtin_bit_cast(float, f2bf(f) << 16); }
__device__ __forceinline__ unsigned cvt_pk_bf16(float lo, float hi) { unsigned r; asm volatile("v_cvt_pk_bf16_f32 %0, %1, %2" : "=v"(r) : "v"(lo), "v"(hi)); return r; }

namespace pg8 {
constexpr int BM = 256, BK = 64, HALF = 128, HTB = HALF * BK * 2, STAGE_BYTES = 8 * HTB, NXCD = 8, WGM = 8;
__host__ __device__ __forceinline__ int lds_byte(int r, int c) { const int st = (r >> 4) * 2 + (c >> 5), rr = r & 15, cc = c & 31, ob = rr * 64 + cc * 2; return st * 1024 + (ob ^ (((ob >> 9) & 1) << 5)); }
__host__ __device__ __forceinline__ void stage_rc(int b, int& R, int& C) { const int st = b / 1024, sb = b % 1024, swz = sb ^ (((sb >> 9) & 1) << 5); R = (st >> 1) * 16 + swz / 64; C = (st & 1) * 32 + (swz % 64) / 2; }
__host__ __device__ __forceinline__ int perm32(int rho) { const int n = rho >> 4, i = rho & 15; return 8 * (i >> 2) + 4 * n + (i & 3); }

struct Unit { int pm, pn; };
struct Gemm { const bf16_t* A; const bf16_t* Bt; int M, N, K, lda, ldb, acol; };

struct StaticOrder {
    int nM, nN, nwg, G, c;
    __device__ void init(int M_, int N_, int G_, int c_) { nM = M_ / BM; nN = N_ / BM; nwg = nM * nN; G = G_; c = c_; }
    __device__ bool next(int i, Unit& u) const {
        const long L = (long)i * G + c; if (L >= nwg) return false;
        int wgid = (int)L; { const int q = nwg / NXCD, r = nwg % NXCD, xcd = wgid % NXCD, off = wgid / NXCD; wgid = (xcd < r ? xcd * (q + 1) : r * (q + 1) + (xcd - r) * q) + off; }
        const int nig = WGM * nN, gid = wgid / nig, fm = gid * WGM, gsz = (nM - fm) < WGM ? (nM - fm) : WGM;
        u.pm = fm + ((wgid % nig) % gsz); u.pn = (wgid % nig) / gsz; return true;
    }
};

__device__ __forceinline__ void row_stats(const float* st, size_t row, float& mu, float& rstd) {
    const f32x4* p = (const f32x4*)(st + row * 8);
    const f32x4 a = p[0], b = p[1];
    const float mean = ((a.x + a.z) + (b.x + b.z)) * 0.25f;
    const float d0 = a.x - mean, d1 = a.z - mean, d2 = b.x - mean, d3 = b.z - mean;
    const float m2 = (a.y + a.w) + (b.y + b.w) + 256.0f * ((d0 * d0 + d1 * d1) + (d2 * d2 + d3 * d3));
    mu = mean; rstd = 1.0f / sqrtf(m2 * (1.0f / 1024.0f) + LN_EPS);
}


struct EpiSwiglu {
    static constexpr bool PERM = true;
    bf16_t* Hout; const float* st; const float* cs; const float* bw;
    __device__ __forceinline__ void operator()(f32x4 (&acc)[2][2][4][2], const Unit& u, int wr, int wc, int fr, int fq, LAS unsigned char*, int, int) const {
        const int tc = u.pn * BM + wc * 32 + 8 * fq, hc = u.pn * HALF + wc * 32 + 8 * fq;
        f32x4 csv[2][2], bwv[2][2];
#pragma unroll
        for (int bj = 0; bj < 2; ++bj)
#pragma unroll
            for (int n = 0; n < 2; ++n) { csv[bj][n] = *(const f32x4*)(cs + tc + bj * HALF + 4 * n); bwv[bj][n] = *(const f32x4*)(bw + tc + bj * HALF + 4 * n); }
#pragma unroll
        for (int ai = 0; ai < 2; ++ai)
#pragma unroll
            for (int m = 0; m < 4; ++m) {
                const size_t row = (size_t)u.pm * BM + ai * HALF + wr * 64 + m * 16 + fr;
                float mu, rs; row_stats(st, row, mu, rs);
                unsigned w[4];
#pragma unroll
                for (int n = 0; n < 2; ++n) {
                    const f32x4 g = (acc[ai][0][m][n] - mu * csv[0][n]) * rs + bwv[0][n];
                    const f32x4 up = (acc[ai][1][m][n] - mu * csv[1][n]) * rs + bwv[1][n];
                    float h[4];
#pragma unroll
                    for (int e = 0; e < 4; ++e) { const float ex = __builtin_amdgcn_exp2f(g[e] * -1.4426950408889634f); h[e] = g[e] * __builtin_amdgcn_rcpf(1.0f + ex) * up[e]; }
                    w[2 * n] = cvt_pk_bf16(h[0], h[1]); w[2 * n + 1] = cvt_pk_bf16(h[2], h[3]);
                }
                *(u32x4*)(Hout + row * FF + hc) = (u32x4){w[0], w[1], w[2], w[3]};
                if (m & 1) asm volatile("" ::: "memory");
            }
    }
};
struct EpiQkv {
    static constexpr bool PERM = true;
    bf16_t* O; size_t stride; const float* st; const float* cs; const float* bw;
    __device__ __forceinline__ void operator()(f32x4 (&acc)[2][2][4][2], const Unit& u, int wr, int wc, int fr, int fq, LAS unsigned char*, int, int) const {
        const int tc = u.pn * BM + wc * 32 + 8 * fq; const int t = u.pn >> 2; const int oc = (u.pn & 3) * BM + wc * 32 + 8 * fq;
        bf16_t* base = O + (size_t)t * stride; const float sc = (t == 0) ? QSCALE : 1.0f;
        f32x4 csv[2][2], bwv[2][2];
#pragma unroll
        for (int bj = 0; bj < 2; ++bj)
#pragma unroll
            for (int n = 0; n < 2; ++n) { csv[bj][n] = *(const f32x4*)(cs + tc + bj * HALF + 4 * n); bwv[bj][n] = *(const f32x4*)(bw + tc + bj * HALF + 4 * n); }
#pragma unroll
        for (int ai = 0; ai < 2; ++ai)
#pragma unroll
            for (int m = 0; m < 4; ++m) {
                const size_t row = (size_t)u.pm * BM + ai * HALF + wr * 64 + m * 16 + fr;
                float mu, rs; row_stats(st, row, mu, rs);
#pragma unroll
                for (int bj = 0; bj < 2; ++bj) {
                    const f32x4 v0 = ((acc[ai][bj][m][0] - mu * csv[bj][0]) * rs + bwv[bj][0]) * sc;
                    const f32x4 v1 = ((acc[ai][bj][m][1] - mu * csv[bj][1]) * rs + bwv[bj][1]) * sc;
                    *(u32x4*)(base + row * D + oc + bj * HALF) = (u32x4){cvt_pk_bf16(v0[0], v0[1]), cvt_pk_bf16(v0[2], v0[3]), cvt_pk_bf16(v1[0], v1[1]), cvt_pk_bf16(v1[2], v1[3])};
                }
                if (m & 1) asm volatile("" ::: "memory");
            }
    }
};
template <int MODE> struct EpiRes {
    static constexpr bool PERM = false;
    const float* base; float* y; bf16_t* yb; const float* stp; float* sto; const float* v0; const float* v1;
    __device__ __forceinline__ void operator()(f32x4 (&acc)[2][2][4][2], const Unit& u, int wr, int wc, int fr, int fq, LAS unsigned char* el, int wid, int lane) const {
        LAS f32x2* P = (LAS f32x2*)el;
        const int col0 = u.pn * BM + wc * 32 + 4 * fq;
        f32x4 ga[2][2], gb[2][2];
#pragma unroll
        for (int bj = 0; bj < 2; ++bj)
#pragma unroll
            for (int n = 0; n < 2; ++n) { const int c = col0 + bj * HALF + n * 16; ga[bj][n] = *(const f32x4*)(v0 + c); if (MODE == 1) gb[bj][n] = *(const f32x4*)(v1 + c) * ALPHA; else gb[bj][n] = (f32x4){0.f, 0.f, 0.f, 0.f}; }
#pragma unroll
        for (int ai = 0; ai < 2; ++ai)
#pragma unroll
            for (int m = 0; m < 4; ++m) {
                const int rl = ai * HALF + wr * 64 + m * 16 + fr; const size_t row = (size_t)u.pm * BM + rl; const size_t off = row * D + col0;
                float mu = 0.f, rs = 0.f; if (MODE == 1) { row_stats(stp, row, mu, rs); rs *= ALPHA; }
                float s = 0.f;
#pragma unroll
                for (int bj = 0; bj < 2; ++bj)
#pragma unroll
                    for (int n = 0; n < 2; ++n) {
                        const f32x4 bs = *(const f32x4*)(base + off + bj * HALF + n * 16); f32x4 v;
                        if (MODE == 0) v = bs * ALPHA + acc[ai][bj][m][n] * ga[bj][n];
                        else v = (bs - mu) * rs * ga[bj][n] + gb[bj][n] + acc[ai][bj][m][n];
                        acc[ai][bj][m][n] = v; s += (v[0] + v[1]) + (v[2] + v[3]);
                        *(f32x4*)(y + off + bj * HALF + n * 16) = v;
                        if (yb) *(u32x2*)(yb + off + bj * HALF + n * 16) = (u32x2){cvt_pk_bf16(v[0], v[1]), cvt_pk_bf16(v[2], v[3])};
                    }
                s += __shfl_xor(s, 16); s += __shfl_xor(s, 32);
                const float mw = s * (1.0f / 64.0f); float q = 0.f;
#pragma unroll
                for (int bj = 0; bj < 2; ++bj)
#pragma unroll
                    for (int n = 0; n < 2; ++n) { const f32x4 d = acc[ai][bj][m][n] - mw; q += (d[0] * d[0] + d[1] * d[1]) + (d[2] * d[2] + d[3] * d[3]); }
                q += __shfl_xor(q, 16); q += __shfl_xor(q, 32);
                if (fq == 0) P[rl * 4 + wc] = (f32x2){mw, q};
                asm volatile("" ::: "memory");
            }
        asm volatile("s_waitcnt lgkmcnt(0)" ::: "memory"); __builtin_amdgcn_s_barrier(); asm volatile("" ::: "memory");
        if (lane < 32) {
            const int row = wid * 32 + lane;
            const f32x2 a = P[row * 4 + 0], b = P[row * 4 + 1], c = P[row * 4 + 2], d = P[row * 4 + 3];
            const float mt = ((a.x + b.x) + (c.x + d.x)) * 0.25f;
            const float da = a.x - mt, db = b.x - mt, dc = c.x - mt, dd = d.x - mt;
            const float m2 = (a.y + b.y) + (c.y + d.y) + 64.0f * ((da * da + db * db) + (dc * dc + dd * dd));
            *(f32x2*)(sto + ((size_t)u.pm * BM + row) * 8 + u.pn * 2) = (f32x2){mt, m2};
        }
        asm volatile("s_waitcnt lgkmcnt(0)" ::: "memory"); __builtin_amdgcn_s_barrier(); asm volatile("" ::: "memory");
    }
};

template <class Epi, class Sched>
__device__ __forceinline__ void gemm_phase(LAS unsigned char* lds, LAS unsigned char* el, const Gemm g, const Sched& S, const Epi& E) {
    int tid = threadIdx.x; asm volatile("" : "+v"(tid));
    const int wid = __builtin_amdgcn_readfirstlane(tid >> 6), lane = tid & 63, wr = wid >> 2, wc = wid & 3, fr = lane & 15, fq = lane >> 4;
    int K = g.K; asm volatile("" : "+s"(K));
    const int nt = K / BK;
    unsigned voffA[2], voffB[2];
#pragma unroll
    for (int i = 0; i < 2; ++i) { int R, C; stage_rc(tid * 16 + i * 8192, R, C); const int Rb = Epi::PERM ? ((R & ~31) + perm32(R & 31)) : R;
        voffA[i] = (unsigned)(R * g.lda + C) * 2u; voffB[i] = (unsigned)(Rb * g.ldb + C) * 2u; }
    const size_t kstep = (size_t)(BK * 2);
    const size_t hstepA = (size_t)HALF * g.lda * 2, hstepB = (size_t)HALF * g.ldb * 2, tstepA = 2 * hstepA, tstepB = 2 * hstepB, cstepA = (size_t)g.acol * 2;
    const unsigned ldsw = (unsigned)wid * 1024u;
    const int aoff = lds_byte(wr * 64 + fr, fq * 8), boff = lds_byte(wc * 32 + fr, fq * 8);
#define PG8_SA(b, h) (((b) * 2 + (h)) * HTB)
#define PG8_SB(b, h) ((4 + (b) * 2 + (h)) * HTB)
#define PG8_STAGE(bufoff, gbase, voff) do { _Pragma("unroll") for (int _i = 0; _i < 2; ++_i) \
        __builtin_amdgcn_global_load_lds((const unsigned*)((const char*)(gbase) + (voff)[_i]), (LAS unsigned*)(lds + (bufoff) + ldsw + _i * 8192), 16, 0, 0); } while (0)
#define PG8_LDA(dst, b, h) do { _Pragma("unroll") for (int m = 0; m < 4; ++m) _Pragma("unroll") for (int k = 0; k < 2; ++k) dst[m][k] = *(const LAS bf16x8*)(lds + PG8_SA(b, h) + aoff + m * 2048 + k * 1024); } while (0)
#define PG8_LDB(dst, b, h) do { _Pragma("unroll") for (int n = 0; n < 2; ++n) _Pragma("unroll") for (int k = 0; k < 2; ++k) dst[n][k] = *(const LAS bf16x8*)(lds + PG8_SB(b, h) + boff + n * 2048 + k * 1024); } while (0)
#define PG8_MMA(ai, bj, At, Bt) do { __builtin_amdgcn_s_setprio(1); _Pragma("unroll") for (int m = 0; m < 4; ++m) _Pragma("unroll") for (int n = 0; n < 2; ++n) _Pragma("unroll") for (int k = 0; k < 2; ++k) \
        acc[ai][bj][m][n] = __builtin_amdgcn_mfma_f32_16x16x32_bf16(Bt[n][k], At[m][k], acc[ai][bj][m][n], 0, 0, 0); __builtin_amdgcn_s_setprio(0); } while (0)
#define PG8_WAIT_V(n) asm volatile("s_waitcnt vmcnt(" #n ")" ::: "memory")
#define PG8_WAIT_L(n) asm volatile("s_waitcnt lgkmcnt(" #n ")" ::: "memory")
#define PG8_BAR __builtin_amdgcn_s_barrier()
#define PG8_SCHED __builtin_amdgcn_sched_barrier(0)
    Unit cur, nxt; int ui = 0;
    if (!S.next(0, cur)) return;
    f32x4 acc[2][2][4][2];
#pragma unroll
    for (int a = 0; a < 2; ++a)
#pragma unroll
        for (int b = 0; b < 2; ++b)
#pragma unroll
            for (int m = 0; m < 4; ++m)
#pragma unroll
                for (int n = 0; n < 2; ++n) acc[a][b][m][n] = (f32x4){0.f, 0.f, 0.f, 0.f};
    bf16x8 At[4][2], B0[2][2], B1[2][2];
    const char* cA = (const char*)g.A + (size_t)cur.pm * tstepA + (size_t)cur.pn * cstepA; const char* cB = (const char*)g.Bt + (size_t)cur.pn * tstepB;
    PG8_STAGE(PG8_SB(0, 0), cB, voffB); PG8_STAGE(PG8_SB(0, 1), cB + hstepB, voffB); PG8_STAGE(PG8_SA(0, 0), cA, voffA); PG8_STAGE(PG8_SA(0, 1), cA + hstepA, voffA);
    if (wr == 1) PG8_BAR;
    PG8_WAIT_V(2); PG8_BAR;
    PG8_STAGE(PG8_SB(1, 0), cB + kstep, voffB); PG8_STAGE(PG8_SA(1, 0), cA + kstep, voffA); PG8_STAGE(PG8_SB(1, 1), cB + hstepB + kstep, voffB);
    PG8_WAIT_V(6); PG8_BAR;
    for (;;) {
        const bool has_next = S.next(ui + 1, nxt);
        const char* nA = has_next ? (const char*)g.A + (size_t)nxt.pm * tstepA + (size_t)nxt.pn * cstepA : cA; const char* nB = has_next ? (const char*)g.Bt + (size_t)nxt.pn * tstepB : cB;
        for (int t = 0; t < nt; t += 2) {
            const bool last = (t == nt - 2);
            const char* a1 = cA + (size_t)(t + 1) * kstep;
            const char* a2 = last ? nA : cA + (size_t)(t + 2) * kstep; const char* b2 = last ? nB : cB + (size_t)(t + 2) * kstep;
            const char* a3 = a2 + kstep; const char* b3 = b2 + kstep;
            PG8_LDB(B0, 0, 0); PG8_LDB(B1, 0, 1); PG8_SCHED; PG8_LDA(At, 0, 0); PG8_STAGE(PG8_SA(1, 1), a1 + hstepA, voffA);
            PG8_WAIT_V(8); PG8_WAIT_L(0); PG8_BAR; PG8_MMA(0, 0, At, B0); PG8_MMA(0, 1, At, B1); PG8_BAR; PG8_SCHED;
            PG8_LDA(At, 0, 1); PG8_STAGE(PG8_SB(0, 0), b2, voffB); PG8_STAGE(PG8_SB(0, 1), b2 + hstepB, voffB); PG8_STAGE(PG8_SA(0, 0), a2, voffA);
            PG8_WAIT_V(8); PG8_WAIT_L(0); PG8_BAR; PG8_MMA(1, 0, At, B0); PG8_MMA(1, 1, At, B1); PG8_BAR; PG8_SCHED;
            PG8_LDB(B0, 1, 0); PG8_LDB(B1, 1, 1); PG8_SCHED; PG8_LDA(At, 1, 0); PG8_STAGE(PG8_SA(0, 1), a2 + hstepA, voffA);
            PG8_WAIT_V(8); PG8_WAIT_L(0); PG8_BAR; PG8_MMA(0, 0, At, B0); PG8_MMA(0, 1, At, B1); PG8_BAR; PG8_SCHED;
            PG8_LDA(At, 1, 1); PG8_STAGE(PG8_SB(1, 0), b3, voffB); PG8_STAGE(PG8_SB(1, 1), b3 + hstepB, voffB); PG8_STAGE(PG8_SA(1, 0), a3, voffA);
            PG8_WAIT_V(8); PG8_WAIT_L(0); PG8_BAR; PG8_MMA(1, 0, At, B0); PG8_MMA(1, 1, At, B1); PG8_BAR; PG8_SCHED;
        }
        if (wr == 0) PG8_BAR;
        { Unit eu = cur; int efr = fr, efq = fq, elane = lane;
          asm volatile("" : "+s"(eu.pm), "+s"(eu.pn), "+v"(efr), "+v"(efq), "+v"(elane));
          E(acc, eu, wr, wc, efr, efq, el, wid, elane); }
        if (!has_next) break;
#pragma unroll
        for (int a = 0; a < 2; ++a)
#pragma unroll
            for (int b = 0; b < 2; ++b)
#pragma unroll
                for (int m = 0; m < 4; ++m)
#pragma unroll
                    for (int n = 0; n < 2; ++n) acc[a][b][m][n] = (f32x4){0.f, 0.f, 0.f, 0.f};
        cur = nxt; cA = nA; cB = nB; ++ui;
        if (wr == 1) PG8_BAR;
    }
    PG8_WAIT_V(0);
    PG8_BAR;
#undef PG8_SA
#undef PG8_SB
#undef PG8_STAGE
#undef PG8_LDA
#undef PG8_LDB
#undef PG8_MMA
#undef PG8_WAIT_V
#undef PG8_WAIT_L
#undef PG8_BAR
#undef PG8_SCHED
}
}

__device__ __forceinline__ int crow(int r, int hi) { return (r & 3) + 8 * (r >> 2) + 4 * hi; }
__device__ __forceinline__ void attn_phase(LAS unsigned char* lds, const bf16_t* Q, const bf16_t* Kp, const bf16_t* Vp, bf16_t* O, int blk, int G) {
    int tid = threadIdx.x; asm volatile("" : "+v"(tid));
    const int lane = tid & 63, r32 = lane & 31, hi = lane >> 5;
    const int wid = __builtin_amdgcn_readfirstlane(tid >> 6);
    LAS unsigned char* vbuf = lds + wid * 8192;
    LAS bf16_t* obuf = (LAS bf16_t*)(vbuf + 4096);
    LAS unsigned char* vrd = vbuf + ((lane >> 4) & 1) * 32 + (lane & 3) * 8 + (4 * hi + ((lane & 15) >> 2)) * 64;
    LAS bf16x8* vw = (LAS bf16x8*)(vbuf + (lane & 1) * 2048 + (lane >> 1) * 64);
    for (int u = blk; u < (NB * NH * SEQ) / 256; u += G) {
        const int bh = u >> 4, qblk = ((u & 15) << 3) + wid;
        const int b = bh >> 4, h = bh & 15;
        const size_t rowb = (size_t)b * SEQ;
        const bf16_t* qp = Q + (rowb + (size_t)qblk * 32 + r32) * D + h * 64 + hi * 32;
        bf16x8 qf[4];
#pragma unroll
        for (int d0 = 0; d0 < 4; ++d0) qf[d0] = *(const bf16x8*)(qp + d0 * 8);
        const bf16_t* kp = Kp + (rowb + r32) * D + h * 64 + hi * 32;
        const bf16_t* vp = Vp + (rowb + (lane >> 1)) * D + h * 64 + (lane & 1) * 32;
        bf16x8 kf[4], vr[4];
#pragma unroll
        for (int d0 = 0; d0 < 4; ++d0) { kf[d0] = *(const bf16x8*)(kp + (size_t)qblk * 32 * D + d0 * 8); vr[d0] = *(const bf16x8*)(vp + (size_t)qblk * 32 * D + d0 * 8); }
        f32x16 o0, o1;
#pragma unroll
        for (int r = 0; r < 16; ++r) { o0[r] = 0.f; o1[r] = 0.f; }
        float carry = 1.0f;
        for (int kt = qblk; kt >= 0; --kt) {
#pragma unroll
            for (int c = 0; c < 4; ++c) vw[c] = vr[c];
            f32x16 s;
#pragma unroll
            for (int r = 0; r < 16; ++r) s[r] = 0.f;
#pragma unroll
            for (int d0 = 0; d0 < 4; ++d0) s = __builtin_amdgcn_mfma_f32_32x32x16_bf16(kf[d0], qf[d0], s, 0, 0, 0);
            if (kt > 0) {
#pragma unroll
                for (int d0 = 0; d0 < 4; ++d0) { kf[d0] = *(const bf16x8*)(kp + (size_t)(kt - 1) * 32 * D + d0 * 8); vr[d0] = *(const bf16x8*)(vp + (size_t)(kt - 1) * 32 * D + d0 * 8); }
            }
            const bool diag = (kt == qblk);
            float e[16], om[16];
#pragma unroll
            for (int r = 0; r < 16; ++r) {
                float ev = __builtin_amdgcn_exp2f(fminf(s[r], 126.0f));
                if (diag && crow(r, hi) >= r32) ev = 0.f;
                e[r] = ev; om[r] = __builtin_amdgcn_rcpf(1.0f + ev);
            }
            float p32[4], p321[4], gp[4], oth[4];
#pragma unroll
            for (int g = 0; g < 4; ++g) { p32[g] = om[4 * g + 3] * om[4 * g + 2]; p321[g] = p32[g] * om[4 * g + 1]; gp[g] = p321[g] * om[4 * g]; }
#pragma unroll
            for (int g = 0; g < 4; ++g) {
                const unsigned own = __float_as_uint(gp[g]);
                auto rr = __builtin_amdgcn_permlane32_swap(own, own, false, false);
                oth[g] = __uint_as_float(rr[0] != own ? rr[0] : rr[1]);
            }
            float E[4];
            E[3] = carry * (hi ? 1.0f : oth[3]);
            E[2] = E[3] * (gp[3] * (hi ? oth[3] : oth[2]));
            E[1] = E[2] * (gp[2] * (hi ? oth[2] : oth[1]));
            E[0] = E[1] * (gp[1] * (hi ? oth[1] : oth[0]));
            carry = E[0] * (gp[0] * (hi ? oth[0] : 1.0f));
            float a[16];
#pragma unroll
            for (int g = 0; g < 4; ++g) {
                a[4 * g + 3] = e[4 * g + 3] * om[4 * g + 3] * E[g];
                a[4 * g + 2] = e[4 * g + 2] * om[4 * g + 2] * (E[g] * om[4 * g + 3]);
                a[4 * g + 1] = e[4 * g + 1] * om[4 * g + 1] * (E[g] * p32[g]);
                a[4 * g + 0] = e[4 * g + 0] * om[4 * g + 0] * (E[g] * p321[g]);
            }
            const u32x4 pw0 = {cvt_pk_bf16(a[0], a[1]), cvt_pk_bf16(a[2], a[3]), cvt_pk_bf16(a[4], a[5]), cvt_pk_bf16(a[6], a[7])};
            const u32x4 pw1 = {cvt_pk_bf16(a[8], a[9]), cvt_pk_bf16(a[10], a[11]), cvt_pk_bf16(a[12], a[13]), cvt_pk_bf16(a[14], a[15])};
            const bf16x8 pa0 = __builtin_bit_cast(bf16x8, pw0), pa1 = __builtin_bit_cast(bf16x8, pw1);
#pragma unroll
            for (int dblk = 0; dblk < 2; ++dblk) {
                const v4i16_t l0 = __builtin_amdgcn_ds_read_tr16_b64_v4i16((LAS v4i16_t*)(vrd + dblk * 2048));
                const v4i16_t h0 = __builtin_amdgcn_ds_read_tr16_b64_v4i16((LAS v4i16_t*)(vrd + dblk * 2048 + 512));
                const v4i16_t l1 = __builtin_amdgcn_ds_read_tr16_b64_v4i16((LAS v4i16_t*)(vrd + dblk * 2048 + 1024));
                const v4i16_t h1 = __builtin_amdgcn_ds_read_tr16_b64_v4i16((LAS v4i16_t*)(vrd + dblk * 2048 + 1536));
                const bf16x8 vf0 = {l0[0], l0[1], l0[2], l0[3], h0[0], h0[1], h0[2], h0[3]};
                const bf16x8 vf1 = {l1[0], l1[1], l1[2], l1[3], h1[0], h1[1], h1[2], h1[3]};
                if (dblk == 0) { o0 = __builtin_amdgcn_mfma_f32_32x32x16_bf16(pa0, vf0, o0, 0, 0, 0); o0 = __builtin_amdgcn_mfma_f32_32x32x16_bf16(pa1, vf1, o0, 0, 0, 0); }
                else           { o1 = __builtin_amdgcn_mfma_f32_32x32x16_bf16(pa0, vf0, o1, 0, 0, 0); o1 = __builtin_amdgcn_mfma_f32_32x32x16_bf16(pa1, vf1, o1, 0, 0, 0); }
            }
            if (!__any(carry >= 1.17549435e-38f)) break;
        }
#pragma unroll
        for (int r = 0; r < 16; ++r) { const int orow = crow(r, hi); obuf[orow * 64 + r32] = (bf16_t)f2bf(o0[r]); obuf[orow * 64 + 32 + r32] = (bf16_t)f2bf(o1[r]); }
        bf16_t* Ow = O + (rowb + (size_t)qblk * 32) * D + h * 64;
#pragma unroll
        for (int i = 0; i < 4; ++i) { const int row = i * 8 + (lane >> 3), ch = lane & 7; const u32x4 v = *(const LAS u32x4*)(obuf + row * 64 + ch * 8); *(u32x4*)(Ow + (size_t)row * D + ch * 8) = v; }
    }
}

template <int RMAP, int FOLD>
__device__ __forceinline__ void transpose_item(const float* W, int K, int N, bf16_t* WT, int row_off, const float* gk, const float* bk, float* csp, float* bwp, LAS float* scr, int item, int lane) {
    const int nblk = N / 32, kb = item / nblk, nb = item % nblk, k0 = 64 * kb, n0 = 32 * nb;
#pragma unroll 16
    for (int i = 0; i < 32; ++i) { const int kk = 2 * i + (lane >> 5); scr[kk * 33 + (lane & 31)] = W[(size_t)(k0 + kk) * N + n0 + (lane & 31)]; }
    asm volatile("s_waitcnt lgkmcnt(0)" ::: "memory");
    const int c = lane & 7;
    f32x4 g0 = {1.f, 1.f, 1.f, 1.f}, g1 = {1.f, 1.f, 1.f, 1.f};
    if (FOLD) { g0 = *(const f32x4*)(gk + k0 + 8 * c); g1 = *(const f32x4*)(gk + k0 + 8 * c + 4); }
#pragma unroll
    for (int j = 0; j < 4; ++j) { const int n = (lane >> 3) + 8 * j; const LAS float* s = scr + (8 * c) * 33 + n;
        u32x4 o; o.x = pk2(s[0 * 33] * g0[0], s[1 * 33] * g0[1]); o.y = pk2(s[2 * 33] * g0[2], s[3 * 33] * g0[3]); o.z = pk2(s[4 * 33] * g1[0], s[5 * 33] * g1[1]); o.w = pk2(s[6 * 33] * g1[2], s[7 * 33] * g1[3]);
        const int nn = n0 + n; const int orow = RMAP ? ((nn >> 7) * 256 + (nn & 127) + row_off) : (row_off + nn);
        *(u32x4*)(WT + (size_t)orow * K + k0 + 8 * c) = o; }
    if (FOLD) {
        const int n = lane & 31, kh = lane >> 5; float cs = 0.f, bw = 0.f;
#pragma unroll 8
        for (int i = 0; i < 32; ++i) { const int kk = kh * 32 + i; const float w = scr[kk * 33 + n]; cs += bfround(w * gk[k0 + kk]); bw += w * bk[k0 + kk]; }
        cs += __shfl_xor(cs, 32); bw += __shfl_xor(bw, 32);
        if (kh == 0) { const int nn = n0 + n; const int orow = RMAP ? ((nn >> 7) * 256 + (nn & 127) + row_off) : (row_off + nn); csp[(size_t)kb * VEC_TOT + orow] = cs; bwp[(size_t)kb * VEC_TOT + orow] = bw; }
    }
    asm volatile("s_waitcnt lgkmcnt(0)" ::: "memory");
}
__device__ __forceinline__ void mix_run(const float* x, bf16_t* mix, int run, int lane) {
    const int t0 = (run & 255) * 16; const size_t row0 = (size_t)run * 16;
    const float* xr = x + row0 * D + 4 * lane;
    f32x4 S[4];
#pragma unroll
    for (int j = 0; j < 4; ++j) { const int w = 2 << j; f32x4 s = {0.f, 0.f, 0.f, 0.f};
#pragma unroll
        for (int i = 1; i < w; ++i) if (t0 - i >= 0) s += *(const f32x4*)(xr - (ptrdiff_t)i * D + 256 * j);
        S[j] = s; }
#pragma unroll 4
    for (int tt = 0; tt < 16; ++tt) {
        const int t = t0 + tt;
#pragma unroll
        for (int j = 0; j < 4; ++j) { const int w = 2 << j;
            const f32x4 xv = *(const f32x4*)(xr + (ptrdiff_t)tt * D + 256 * j);
            S[j] += xv;
            const int cnt = (t + 1 < w) ? (t + 1) : w; const float inv = 1.0f / (float)cnt;
            const f32x4 mx = S[j] * inv - xv;
            *(u32x2*)(mix + (row0 + tt) * D + 256 * j + 4 * lane) = (u32x2){pk2(mx[0], mx[1]), pk2(mx[2], mx[3])};
            if (t - w + 1 >= 0) S[j] -= *(const f32x4*)(xr + (ptrdiff_t)(tt - w + 1) * D + 256 * j);
        }
    }
}

#define XB_TMO      128
#define XB_XCNT(j)  (256  + 64 * (j))
#define XB_XSUB(j)  (1280 + 64 * (j))
#define XB_XGEN(j)  (2304 + 64 * (j))
#define XB_TOP      3328
#define XB_TOPGEN   3392
#define XCD_BAR_WORDS 3456
#define XB_SPIN_CAP (1u << 22)
__device__ __forceinline__ unsigned xb_ld(unsigned* p)              { return __hip_atomic_load(p, __ATOMIC_RELAXED, __HIP_MEMORY_SCOPE_AGENT); }
__device__ __forceinline__ unsigned xb_add(unsigned* p, unsigned v) { return __hip_atomic_fetch_add(p, v, __ATOMIC_RELAXED, __HIP_MEMORY_SCOPE_AGENT); }
__device__ __forceinline__ unsigned xb_xcc_id() { return (unsigned)__builtin_amdgcn_s_getreg((3 << 11) | 20) & 0xFu; }
#define XB_SPIN(cond, bar) do { unsigned _sp = 0; while (cond) { __builtin_amdgcn_s_sleep(1); \
    if ((++_sp & 255u) == 0u) { if (xb_ld(&(bar)[XB_TMO])) break; if (_sp > XB_SPIN_CAP) { atomicAdd(&(bar)[XB_TMO], 1u); break; } } } } while (0)
struct XcdBarrier { unsigned* bar; unsigned x; volatile LAS unsigned* st; };
__device__ __forceinline__ XcdBarrier xcd_barrier_post(unsigned* bar, volatile LAS unsigned* st) {
    XcdBarrier b; b.bar = bar; b.x = xb_xcc_id(); b.st = st;
    if (threadIdx.x == 0) (void)xb_add(&bar[XB_XCNT(b.x)], 1u);
    return b;
}
__device__ __forceinline__ void xcd_barrier_complete(unsigned* bar, unsigned x, unsigned& nloc, unsigned& nx) {
    const unsigned G = gridDim.x * gridDim.y * gridDim.z;
    unsigned sum, cnt, mine, sp = 0u;
    for (;;) {
        sum = 0u; cnt = 0u; mine = 0u;
#pragma unroll
        for (unsigned j = 0; j < 16; ++j) { const unsigned c = xb_ld(&bar[XB_XCNT(j)]); sum += c; cnt += (c > 0u) ? 1u : 0u; mine = (j == x) ? c : mine; }
        if (sum == G) break;
        __builtin_amdgcn_s_sleep(1);
        if ((++sp & 255u) == 0u) { if (xb_ld(&bar[XB_TMO])) break; if (sp > XB_SPIN_CAP) { atomicAdd(&bar[XB_TMO], 1u); break; } }
    }
    nloc = mine > 0u ? mine : 1u; nx = cnt > 0u ? cnt : 1u;
}
__device__ __forceinline__ void xcd_barrier(const XcdBarrier& b) {
    asm volatile("s_waitcnt vmcnt(0)" ::: "memory");
    __syncthreads();
    if (threadIdx.x == 0) {
        unsigned* bar = b.bar;
        __builtin_amdgcn_s_waitcnt(0);
        unsigned nloc = b.st[0], nx = b.st[1];
        if (nloc == 0u) { xcd_barrier_complete(bar, b.x, nloc, nx); b.st[0] = nloc; b.st[1] = nx; }
        const unsigned old = xb_add(&bar[XB_XSUB(b.x)], 1u);
        const unsigned gen = old / nloc;
        if (old + 1u == (gen + 1u) * nloc) {
            __builtin_amdgcn_fence(__ATOMIC_RELEASE, "agent");
            asm volatile("s_waitcnt vmcnt(0)" ::: "memory");
            const unsigned og = xb_add(&bar[XB_TOP], 1u);
            const unsigned tg = og / nx;
            if (og + 1u == (tg + 1u) * nx) xb_add(&bar[XB_TOPGEN], 1u);
            else XB_SPIN(xb_ld(&bar[XB_TOPGEN]) == tg, bar);
            __builtin_amdgcn_fence(__ATOMIC_ACQUIRE, "agent");
            xb_add(&bar[XB_XGEN(b.x)], 1u);
            asm volatile("s_waitcnt vmcnt(0)" ::: "memory");
        } else {
            XB_SPIN(xb_ld(&bar[XB_XGEN(b.x)]) == gen, bar);
            __builtin_amdgcn_fence(__ATOMIC_ACQUIRE, "agent");
            asm volatile("s_waitcnt vmcnt(0)" ::: "memory");
        }
    }
    __syncthreads();
}

#ifndef USE_CG_SYNC
#define USE_CG_SYNC 0
#endif

struct Args { const float* in[12]; float* out; unsigned char* ws; };
__global__ void __launch_bounds__(512, 2) fwd_megakernel(Args args) {
    extern __shared__ __attribute__((aligned(16))) unsigned char lds_raw[];
    LAS unsigned char* lds = (LAS unsigned char*)lds_raw;
    LAS unsigned char* el = lds + EPI_OFF;
    volatile LAS unsigned* MISC = (volatile LAS unsigned*)(lds + MISC_OFF);
    const int tid = threadIdx.x, wave = __builtin_amdgcn_readfirstlane(tid >> 6);
    const int G = gridDim.x, blk = blockIdx.x;
    cg::grid_group grid = cg::this_grid();
    unsigned char* ws = args.ws;
    const float* x = args.in[0]; const float* ln_mix_g = args.in[1]; const float* ln_mix_b = args.in[2]; const float* ln_ffn_g = args.in[3]; const float* ln_ffn_b = args.in[4];
    const float* pool_w = args.in[5]; const float* pool_scale = args.in[6]; const float* w_qkv = args.in[7]; const float* w_o = args.in[8];
    const float* w_gate = args.in[9]; const float* w_up = args.in[10]; const float* w_down = args.in[11];
    float* Y = args.out;
    float* vec = (float*)(ws + WS_VEC);
    float* ST1 = (float*)(ws + WS_ST), *ST2 = (float*)(ws + WS_ST + 1 * MiB), *ST3 = (float*)(ws + WS_ST + 2 * MiB), *ST4 = (float*)(ws + WS_ST + 3 * MiB);
    bf16_t* WPOOL = (bf16_t*)(ws + WS_WPOOL), *WQKV = (bf16_t*)(ws + WS_WQKV), *WO = (bf16_t*)(ws + WS_WO), *WGU0 = (bf16_t*)(ws + WS_WGU0), *WGU1 = (bf16_t*)(ws + WS_WGU1), *WD0 = (bf16_t*)(ws + WS_WD0), *WD1 = (bf16_t*)(ws + WS_WD1);
    bf16_t* XB = (bf16_t*)(ws + WS_XB), *HB = (bf16_t*)(ws + WS_H), *QB = (bf16_t*)(ws + WS_Q), *KB = (bf16_t*)(ws + WS_K), *VB = (bf16_t*)(ws + WS_V), *OB = (bf16_t*)(ws + WS_O), *MIX = (bf16_t*)(ws + WS_MIX);

    if (tid < 64) MISC[tid] = 0u;
    __syncthreads();
#if USE_CG_SYNC
#define GRID_BAR() grid.sync()
#else
    if (args.ws == nullptr) grid.sync();
    XcdBarrier bar = xcd_barrier_post((unsigned*)(ws + WS_BAR), MISC + 8);
#define GRID_BAR() xcd_barrier(bar)
#endif

    {
        int lane = tid & 63; asm volatile("" : "+v"(lane));
        const int gw = blk * 8 + wave, NGW = G * 8;
        for (int run = gw; run < M / 16; run += NGW) mix_run(x, MIX, run, lane);
        LAS float* scr = (LAS float*)(lds + wave * 16384);
        float* vp = (float*)(ws + WS_VPART);
        constexpr int I_POOL = 4 * 4 * 8, I_QKV = 16 * 96, I_WO = 16 * 32, I_G = 16 * 88, I_D = 44 * 32;
        constexpr int NITEMS = I_POOL + I_QKV + I_WO + 4 * I_G + 2 * I_D;
        for (int it = gw; it < NITEMS; it += NGW) {
            int r = it;
            if (r < I_POOL) { const int g = r >> 5; transpose_item<0, 0>(pool_w + (size_t)g * 65536, 256, 256, WPOOL, g * 256, nullptr, nullptr, nullptr, nullptr, scr, r & 31, lane); continue; } r -= I_POOL;
            if (r < I_QKV) { transpose_item<0, 1>(w_qkv, D, NQKV, WQKV, 0, ln_ffn_g, ln_ffn_b, vp + V_CS_QKV, vp + V_BW_QKV, scr, r, lane); continue; } r -= I_QKV;
            if (r < I_WO) { transpose_item<0, 0>(w_o, D, D, WO, 0, nullptr, nullptr, nullptr, nullptr, scr, r, lane); continue; } r -= I_WO;
            if (r < I_G) { transpose_item<1, 1>(w_gate, D, FF, WGU0, 0, ln_mix_g, ln_mix_b, vp + V_CS_GU0, vp + V_BW_GU0, scr, r, lane); continue; } r -= I_G;
            if (r < I_G) { transpose_item<1, 1>(w_up, D, FF, WGU0, 128, ln_mix_g, ln_mix_b, vp + V_CS_GU0, vp + V_BW_GU0, scr, r, lane); continue; } r -= I_G;
            if (r < I_G) { transpose_item<1, 1>(w_gate + (size_t)D * FF, D, FF, WGU1, 0, ln_mix_g + D, ln_mix_b + D, vp + V_CS_GU1, vp + V_BW_GU1, scr, r, lane); continue; } r -= I_G;
            if (r < I_G) { transpose_item<1, 1>(w_up + (size_t)D * FF, D, FF, WGU1, 128, ln_mix_g + D, ln_mix_b + D, vp + V_CS_GU1, vp + V_BW_GU1, scr, r, lane); continue; } r -= I_G;
            if (r < I_D) { transpose_item<0, 0>(w_down, FF, D, WD0, 0, nullptr, nullptr, nullptr, nullptr, scr, r, lane); continue; } r -= I_D;
            transpose_item<0, 0>(w_down + (size_t)FF * D, FF, D, WD1, 0, nullptr, nullptr, nullptr, nullptr, scr, r, lane);
        }
    }
    GRID_BAR();
    { int idx = blk * 512 + tid; asm volatile("" : "+v"(idx));
      if (idx < VEC_TOT) { const float* vp = (const float*)(ws + WS_VPART) + idx; float a = 0.f;
#pragma unroll
          for (int k = 0; k < 16; ++k) a += vp[(size_t)k * VEC_TOT];
          vec[idx] = a; } }
    pg8::StaticOrder S;
    { pg8::Gemm g{MIX, WPOOL, M, D, 256, D, 256, 256}; S.init(M, D, G, blk);
      pg8::EpiRes<0> E{x, Y, XB, nullptr, ST1, pool_scale, nullptr};
      pg8::gemm_phase(lds, el, g, S, E); }
    GRID_BAR();
    { pg8::Gemm g{XB, WGU0, M, NGU, D, D, D, 0}; S.init(M, NGU, G, blk);
      pg8::EpiSwiglu E{HB, ST1, vec + V_CS_GU0, vec + V_BW_GU0};
      pg8::gemm_phase(lds, el, g, S, E); }
    GRID_BAR();
    { pg8::Gemm g{HB, WD0, M, D, FF, FF, FF, 0}; S.init(M, D, G, blk);
      pg8::EpiRes<1> E{Y, Y, XB, ST1, ST2, ln_mix_g, ln_mix_b};
      pg8::gemm_phase(lds, el, g, S, E); }
    GRID_BAR();
    { pg8::Gemm g{XB, WQKV, M, NQKV, D, D, D, 0}; S.init(M, NQKV, G, blk);
      pg8::EpiQkv E{QB, (size_t)M * D, ST2, vec + V_CS_QKV, vec + V_BW_QKV};
      pg8::gemm_phase(lds, el, g, S, E); }
    GRID_BAR();
    attn_phase(lds, QB, KB, VB, OB, blk, G);
    GRID_BAR();
    { pg8::Gemm g{OB, WO, M, D, D, D, D, 0}; S.init(M, D, G, blk);
      pg8::EpiRes<1> E{Y, Y, XB, ST2, ST3, ln_ffn_g, ln_ffn_b};
      pg8::gemm_phase(lds, el, g, S, E); }
    GRID_BAR();
    { pg8::Gemm g{XB, WGU1, M, NGU, D, D, D, 0}; S.init(M, NGU, G, blk);
      pg8::EpiSwiglu E{HB, ST3, vec + V_CS_GU1, vec + V_BW_GU1};
      pg8::gemm_phase(lds, el, g, S, E); }
    GRID_BAR();
    { pg8::Gemm g{HB, WD1, M, D, FF, FF, FF, 0}; S.init(M, D, G, blk);
      pg8::EpiRes<1> E{Y, Y, nullptr, ST3, ST4, ln_mix_g + D, ln_mix_b + D};
      pg8::gemm_phase(lds, el, g, S, E); }
    GRID_BAR();
    {
        int lane = tid & 63; asm volatile("" : "+v"(lane));
        const int gw = blk * 8 + wave, NGW = G * 8;
        const float* gg = ln_ffn_g + D; const float* bb = ln_ffn_b + D;
        f32x4 gv[4], bv[4];
#pragma unroll
        for (int j = 0; j < 4; ++j) { gv[j] = *(const f32x4*)(gg + 256 * j + 4 * lane); bv[j] = *(const f32x4*)(bb + 256 * j + 4 * lane); }
        for (int row = gw; row < M; row += NGW) {
            float mu, rs; pg8::row_stats(ST4, (size_t)row, mu, rs);
            float* yr = Y + (size_t)row * D + 4 * lane;
#pragma unroll
            for (int j = 0; j < 4; ++j) { const f32x4 v = *(const f32x4*)(yr + 256 * j); *(f32x4*)(yr + 256 * j) = (v - mu) * rs * gv[j] + bv[j]; }
        }
    }
}

extern "C" void kernel_launch(void* const* d_in, const int* in_sizes, int n_in, void* d_out, int out_size, void* d_ws, size_t ws_size, hipStream_t stream) {
    static int grid = 0;
    if (grid == 0) {
        if (n_in != 12 || in_sizes[0] != M * D || out_size != M * D || ws_size < WS_END) { fprintf(stderr, "kernel_launch: unexpected shapes (n_in %d, in0 %d, out %d, ws %zu)\n", n_in, n_in > 0 ? in_sizes[0] : -1, out_size, ws_size); grid = -1; return; }
        int dev = 0, cus = 0, per_cu = 0;
        if (hipGetDevice(&dev) != hipSuccess || hipDeviceGetAttribute(&cus, hipDeviceAttributeMultiprocessorCount, dev) != hipSuccess) { grid = -1; return; }
        if (hipFuncSetAttribute((const void*)fwd_megakernel, hipFuncAttributeMaxDynamicSharedMemorySize, LDS_BYTES) != hipSuccess) { fprintf(stderr, "kernel_launch: hipFuncSetAttribute failed\n"); grid = -1; return; }
        if (hipOccupancyMaxActiveBlocksPerMultiprocessor(&per_cu, (const void*)fwd_megakernel, 512, LDS_BYTES) != hipSuccess || per_cu < 1) { fprintf(stderr, "kernel_launch: occupancy query gave %d\n", per_cu); per_cu = 1; }
        (void)hipGetLastError();
        grid = cus * per_cu; if (grid > 256) grid = 256;
    }
    if (grid < 0) return;
    (void)hipMemsetAsync((char*)d_ws + WS_BAR, 0, XCD_BAR_WORDS * 4, stream);
    Args a{};
    for (int i = 0; i < 12; ++i) a.in[i] = (const float*)d_in[i];
    a.out = (float*)d_out; a.ws = (unsigned char*)d_ws;
    void* kargs[] = {&a};
    hipError_t e = hipLaunchCooperativeKernel((const void*)fwd_megakernel, dim3(grid), dim3(512), kargs, LDS_BYTES, stream);
    if (e != hipSuccess) fprintf(stderr, "kernel_launch: cooperative launch failed: %s (grid %d)\n", hipGetErrorString(e), grid);
}
```

```cpp
#include <hip/hip_runtime.h>
#include <hip/hip_cooperative_groups.h>
#include <cstdio>
#include <cstdint>
namespace cg = cooperative_groups;

#define LAS __attribute__((address_space(3)))
typedef unsigned short bf16_t;
typedef short bf16x8 __attribute__((ext_vector_type(8)));
typedef float f32x4 __attribute__((ext_vector_type(4)));
typedef float f32x2 __attribute__((ext_vector_type(2)));
typedef float f32x16 __attribute__((ext_vector_type(16)));
typedef unsigned u32x4 __attribute__((ext_vector_type(4)));
typedef unsigned u32x2 __attribute__((ext_vector_type(2)));
typedef short v4i16_t __attribute__((ext_vector_type(4)));

constexpr int SEQ = 4096, NB = 8, M = NB * SEQ, D = 1024, FF = 2816, NGU = 2 * FF, NQKV = 3 * D, NH = 16;
constexpr float ALPHA = 1.41421356237309515f;
constexpr float LN_EPS = 1e-5f;
constexpr float QSCALE = 0.125f * 1.4426950408889634f;

constexpr size_t MiB = 1u << 20;
constexpr size_t WS_BAR = 0;
constexpr size_t WS_VEC = 1 * MiB;
constexpr size_t WS_ST = 2 * MiB;
constexpr size_t WS_WPOOL = 8 * MiB, WS_WQKV = 9 * MiB, WS_WO = 15 * MiB, WS_WGU0 = 17 * MiB, WS_WGU1 = 28 * MiB, WS_WD0 = 39 * MiB, WS_WD1 = 45 * MiB;
constexpr size_t WS_XB = 64 * MiB;
constexpr size_t WS_R = 128 * MiB;
constexpr size_t WS_H = WS_R, WS_Q = WS_R, WS_K = WS_R + 64 * MiB, WS_V = WS_R + 128 * MiB, WS_O = WS_R + 192 * MiB, WS_MIX = WS_R + 192 * MiB;
constexpr size_t WS_END = WS_R + 256 * MiB;
constexpr int V_CS_QKV = 0, V_BW_QKV = 3072, V_CS_GU0 = 6144, V_BW_GU0 = V_CS_GU0 + NGU, V_CS_GU1 = V_BW_GU0 + NGU, V_BW_GU1 = V_CS_GU1 + NGU;
constexpr int VEC_TOT = V_BW_GU1 + NGU;
constexpr size_t WS_VPART = 6 * MiB;

constexpr int RING_BYTES = 131072, EPI_OFF = RING_BYTES, EPI_BYTES = 8192, MISC_OFF = EPI_OFF + EPI_BYTES, LDS_BYTES = MISC_OFF + 256;

typedef _Float16 h16x8 __attribute__((ext_vector_type(8)));
typedef _Float16 h16x4 __attribute__((ext_vector_type(4)));
typedef _Float16 h16x2 __attribute__((ext_vector_type(2)));
__device__ __forceinline__ unsigned f2bf(float f) { return (unsigned)__builtin_bit_cast(unsigned short, (_Float16)f); }
__device__ __forceinline__ unsigned pk2(float lo, float hi) { const h16x2 p = {(_Float16)lo, (_Float16)hi}; return __builtin_bit_cast(unsigned, p); }
__device__ __forceinline__ float bfround(float f) { return (float)(_Float16)f; }
__device__ __forceinline__ unsigned cvt_pk_bf16(float lo, float hi) { return pk2(lo, hi); }
__device__ __forceinline__ f32x4 h4_to_f4(u32x2 raw) { return __builtin_convertvector(__builtin_bit_cast(h16x4, raw), f32x4); }
__device__ __forceinline__ u32x2 f4_to_h4(f32x4 v) { return __builtin_bit_cast(u32x2, __builtin_convertvector(v, h16x4)); }

namespace pg8 {
constexpr int BM = 256, BK = 64, HALF = 128, HTB = HALF * BK * 2, STAGE_BYTES = 8 * HTB, NXCD = 8, WGM = 8;
__host__ __device__ __forceinline__ int lds_byte(int r, int c) { const int st = (r >> 4) * 2 + (c >> 5), rr = r & 15, cc = c & 31, ob = rr * 64 + cc * 2; return st * 1024 + (ob ^ (((ob >> 9) & 1) << 5)); }
__host__ __device__ __forceinline__ void stage_rc(int b, int& R, int& C) { const int st = b / 1024, sb = b % 1024, swz = sb ^ (((sb >> 9) & 1) << 5); R = (st >> 1) * 16 + swz / 64; C = (st & 1) * 32 + (swz % 64) / 2; }
__host__ __device__ __forceinline__ int perm32(int rho) { const int n = rho >> 4, i = rho & 15; return 8 * (i >> 2) + 4 * n + (i & 3); }

struct Unit { int pm, pn; };
struct Gemm { const bf16_t* A; const bf16_t* Bt; int M, N, K, lda, ldb, acol; };

struct StaticOrder {
    int nM, nN, nwg, G, c;
    __device__ void init(int M_, int N_, int G_, int c_) { nM = M_ / BM; nN = N_ / BM; nwg = nM * nN; G = G_; c = c_; }
    __device__ bool next(int i, Unit& u) const {
        const long L = (long)i * G + c; if (L >= nwg) return false;
        int wgid = (int)L; { const int q = nwg / NXCD, r = nwg % NXCD, xcd = wgid % NXCD, off = wgid / NXCD; wgid = (xcd < r ? xcd * (q + 1) : r * (q + 1) + (xcd - r) * q) + off; }
        const int nig = WGM * nN, gid = wgid / nig, fm = gid * WGM, gsz = (nM - fm) < WGM ? (nM - fm) : WGM;
        u.pm = fm + ((wgid % nig) % gsz); u.pn = (wgid % nig) / gsz; return true;
    }
};

__device__ __forceinline__ void row_stats(const float* st, size_t row, float& mu, float& rstd) {
    const f32x4* p = (const f32x4*)(st + row * 8);
    const f32x4 a = p[0], b = p[1];
    const float mean = ((a.x + a.z) + (b.x + b.z)) * 0.25f;
    const float d0 = a.x - mean, d1 = a.z - mean, d2 = b.x - mean, d3 = b.z - mean;
    const float m2 = (a.y + a.w) + (b.y + b.w) + 256.0f * ((d0 * d0 + d1 * d1) + (d2 * d2 + d3 * d3));
    mu = mean; rstd = 1.0f / sqrtf(m2 * (1.0f / 1024.0f) + LN_EPS);
}


struct EpiSwiglu {
    static constexpr bool PERM = true;
    bf16_t* Hout; const float* st; const float* cs; const float* bw;
    __device__ __forceinline__ void operator()(f32x4 (&acc)[2][2][4][2], const Unit& u, int wr, int wc, int fr, int fq, LAS unsigned char*, int, int) const {
        const int tc = u.pn * BM + wc * 32 + 8 * fq, hc = u.pn * HALF + wc * 32 + 8 * fq;
        f32x4 csv[2][2], bwv[2][2];
#pragma unroll
        for (int bj = 0; bj < 2; ++bj)
#pragma unroll
            for (int n = 0; n < 2; ++n) { csv[bj][n] = *(const f32x4*)(cs + tc + bj * HALF + 4 * n); bwv[bj][n] = *(const f32x4*)(bw + tc + bj * HALF + 4 * n); }
#pragma unroll
        for (int ai = 0; ai < 2; ++ai)
#pragma unroll
            for (int m = 0; m < 4; ++m) {
                const size_t row = (size_t)u.pm * BM + ai * HALF + wr * 64 + m * 16 + fr;
                float mu, rs; row_stats(st, row, mu, rs);
                unsigned w[4];
#pragma unroll
                for (int n = 0; n < 2; ++n) {
                    const f32x4 g = (acc[ai][0][m][n] - mu * csv[0][n]) * rs + bwv[0][n];
                    const f32x4 up = (acc[ai][1][m][n] - mu * csv[1][n]) * rs + bwv[1][n];
                    float h[4];
#pragma unroll
                    for (int e = 0; e < 4; ++e) { const float ex = __builtin_amdgcn_exp2f(g[e] * -1.4426950408889634f); h[e] = g[e] * __builtin_amdgcn_rcpf(1.0f + ex) * up[e]; }
                    w[2 * n] = cvt_pk_bf16(h[0], h[1]); w[2 * n + 1] = cvt_pk_bf16(h[2], h[3]);
                }
                *(u32x4*)(Hout + row * FF + hc) = (u32x4){w[0], w[1], w[2], w[3]};
                if (m & 1) asm volatile("" ::: "memory");
            }
    }
};
struct EpiQkv {
    static constexpr bool PERM = true;
    bf16_t* O; size_t stride; const float* st; const float* cs; const float* bw;
    __device__ __forceinline__ void operator()(f32x4 (&acc)[2][2][4][2], const Unit& u, int wr, int wc, int fr, int fq, LAS unsigned char*, int, int) const {
        const int tc = u.pn * BM + wc * 32 + 8 * fq; const int t = u.pn >> 2; const int oc = (u.pn & 3) * BM + wc * 32 + 8 * fq;
        bf16_t* base = O + (size_t)t * stride; const float sc = (t == 0) ? QSCALE : 1.0f;
        f32x4 csv[2][2], bwv[2][2];
#pragma unroll
        for (int bj = 0; bj < 2; ++bj)
#pragma unroll
            for (int n = 0; n < 2; ++n) { csv[bj][n] = *(const f32x4*)(cs + tc + bj * HALF + 4 * n); bwv[bj][n] = *(const f32x4*)(bw + tc + bj * HALF + 4 * n); }
#pragma unroll
        for (int ai = 0; ai < 2; ++ai)
#pragma unroll
            for (int m = 0; m < 4; ++m) {
                const size_t row = (size_t)u.pm * BM + ai * HALF + wr * 64 + m * 16 + fr;
                float mu, rs; row_stats(st, row, mu, rs);
#pragma unroll
                for (int bj = 0; bj < 2; ++bj) {
                    const f32x4 v0 = ((acc[ai][bj][m][0] - mu * csv[bj][0]) * rs + bwv[bj][0]) * sc;
                    const f32x4 v1 = ((acc[ai][bj][m][1] - mu * csv[bj][1]) * rs + bwv[bj][1]) * sc;
                    *(u32x4*)(base + row * D + oc + bj * HALF) = (u32x4){cvt_pk_bf16(v0[0], v0[1]), cvt_pk_bf16(v0[2], v0[3]), cvt_pk_bf16(v1[0], v1[1]), cvt_pk_bf16(v1[2], v1[3])};
                }
                if (m & 1) asm volatile("" ::: "memory");
            }
    }
};
template <int MODE> struct EpiRes {
    static constexpr bool PERM = false;
    const void* base; bf16_t* y; const float* stp; float* sto; const float* v0; const float* v1;
    __device__ __forceinline__ void operator()(f32x4 (&acc)[2][2][4][2], const Unit& u, int wr, int wc, int fr, int fq, LAS unsigned char* el, int wid, int lane) const {
        LAS f32x2* P = (LAS f32x2*)el;
        const int col0 = u.pn * BM + wc * 32 + 4 * fq;
        f32x4 ga[2][2], gb[2][2];
#pragma unroll
        for (int bj = 0; bj < 2; ++bj)
#pragma unroll
            for (int n = 0; n < 2; ++n) { const int c = col0 + bj * HALF + n * 16; ga[bj][n] = *(const f32x4*)(v0 + c); if (MODE == 1) gb[bj][n] = *(const f32x4*)(v1 + c) * ALPHA; else gb[bj][n] = (f32x4){0.f, 0.f, 0.f, 0.f}; }
#pragma unroll
        for (int ai = 0; ai < 2; ++ai)
#pragma unroll
            for (int m = 0; m < 4; ++m) {
                const int rl = ai * HALF + wr * 64 + m * 16 + fr; const size_t row = (size_t)u.pm * BM + rl; const size_t off = row * D + col0;
                float mu = 0.f, rs = 0.f; if (MODE == 1) { row_stats(stp, row, mu, rs); rs *= ALPHA; }
                float s = 0.f;
#pragma unroll
                for (int bj = 0; bj < 2; ++bj)
#pragma unroll
                    for (int n = 0; n < 2; ++n) {
                        f32x4 v;
                        if (MODE == 0) { const f32x4 bs = *(const f32x4*)((const float*)base + off + bj * HALF + n * 16); v = bs * ALPHA + acc[ai][bj][m][n] * ga[bj][n]; }
                        else { const f32x4 bs = h4_to_f4(*(const u32x2*)((const bf16_t*)base + off + bj * HALF + n * 16)); v = (bs - mu) * rs * ga[bj][n] + gb[bj][n] + acc[ai][bj][m][n]; }
                        const u32x2 hv = f4_to_h4(v);
                        *(u32x2*)(y + off + bj * HALF + n * 16) = hv;
                        v = h4_to_f4(hv);
                        acc[ai][bj][m][n] = v; s += (v[0] + v[1]) + (v[2] + v[3]);
                    }
                s += __shfl_xor(s, 16); s += __shfl_xor(s, 32);
                const float mw = s * (1.0f / 64.0f); float q = 0.f;
#pragma unroll
                for (int bj = 0; bj < 2; ++bj)
#pragma unroll
                    for (int n = 0; n < 2; ++n) { const f32x4 d = acc[ai][bj][m][n] - mw; q += (d[0] * d[0] + d[1] * d[1]) + (d[2] * d[2] + d[3] * d[3]); }
                q += __shfl_xor(q, 16); q += __shfl_xor(q, 32);
                if (fq == 0) P[rl * 4 + wc] = (f32x2){mw, q};
                asm volatile("" ::: "memory");
            }
        asm volatile("s_waitcnt lgkmcnt(0)" ::: "memory"); __builtin_amdgcn_s_barrier(); asm volatile("" ::: "memory");
        if (lane < 32) {
            const int row = wid * 32 + lane;
            const f32x2 a = P[row * 4 + 0], b = P[row * 4 + 1], c = P[row * 4 + 2], d = P[row * 4 + 3];
            const float mt = ((a.x + b.x) + (c.x + d.x)) * 0.25f;
            const float da = a.x - mt, db = b.x - mt, dc = c.x - mt, dd = d.x - mt;
            const float m2 = (a.y + b.y) + (c.y + d.y) + 64.0f * ((da * da + db * db) + (dc * dc + dd * dd));
            *(f32x2*)(sto + ((size_t)u.pm * BM + row) * 8 + u.pn * 2) = (f32x2){mt, m2};
        }
        asm volatile("s_waitcnt lgkmcnt(0)" ::: "memory"); __builtin_amdgcn_s_barrier(); asm volatile("" ::: "memory");
    }
};

template <class Epi, class Sched>
__device__ __forceinline__ void gemm_phase(LAS unsigned char* lds, LAS unsigned char* el, const Gemm g, const Sched& S, const Epi& E) {
    int tid = threadIdx.x; asm volatile("" : "+v"(tid));
    const int wid = __builtin_amdgcn_readfirstlane(tid >> 6), lane = tid & 63, wr = wid >> 2, wc = wid & 3, fr = lane & 15, fq = lane >> 4;
    int K = g.K; asm volatile("" : "+s"(K));
    const int nt = K / BK;
    unsigned voffA[2], voffB[2];
#pragma unroll
    for (int i = 0; i < 2; ++i) { int R, C; stage_rc(tid * 16 + i * 8192, R, C); const int Rb = Epi::PERM ? ((R & ~31) + perm32(R & 31)) : R;
        voffA[i] = (unsigned)(R * g.lda + C) * 2u; voffB[i] = (unsigned)(Rb * g.ldb + C) * 2u; }
    const size_t kstep = (size_t)(BK * 2);
    const size_t hstepA = (size_t)HALF * g.lda * 2, hstepB = (size_t)HALF * g.ldb * 2, tstepA = 2 * hstepA, tstepB = 2 * hstepB, cstepA = (size_t)g.acol * 2;
    const unsigned ldsw = (unsigned)wid * 1024u;
    const int aoff = lds_byte(wr * 64 + fr, fq * 8), boff = lds_byte(wc * 32 + fr, fq * 8);
#define PG8_SA(b, h) (((b) * 2 + (h)) * HTB)
#define PG8_SB(b, h) ((4 + (b) * 2 + (h)) * HTB)
#define PG8_STAGE(bufoff, gbase, voff) do { _Pragma("unroll") for (int _i = 0; _i < 2; ++_i) \
        __builtin_amdgcn_global_load_lds((const unsigned*)((const char*)(gbase) + (voff)[_i]), (LAS unsigned*)(lds + (bufoff) + ldsw + _i * 8192), 16, 0, 0); } while (0)
#define PG8_LDA(dst, b, h) do { _Pragma("unroll") for (int m = 0; m < 4; ++m) _Pragma("unroll") for (int k = 0; k < 2; ++k) dst[m][k] = *(const LAS bf16x8*)(lds + PG8_SA(b, h) + aoff + m * 2048 + k * 1024); } while (0)
#define PG8_LDB(dst, b, h) do { _Pragma("unroll") for (int n = 0; n < 2; ++n) _Pragma("unroll") for (int k = 0; k < 2; ++k) dst[n][k] = *(const LAS bf16x8*)(lds + PG8_SB(b, h) + boff + n * 2048 + k * 1024); } while (0)
#define PG8_MMA(ai, bj, At, Bt) do { __builtin_amdgcn_s_setprio(1); _Pragma("unroll") for (int m = 0; m < 4; ++m) _Pragma("unroll") for (int n = 0; n < 2; ++n) _Pragma("unroll") for (int k = 0; k < 2; ++k) \
        acc[ai][bj][m][n] = __builtin_amdgcn_mfma_f32_16x16x32_f16(__builtin_bit_cast(h16x8, Bt[n][k]), __builtin_bit_cast(h16x8, At[m][k]), acc[ai][bj][m][n], 0, 0, 0); __builtin_amdgcn_s_setprio(0); } while (0)
#define PG8_WAIT_V(n) asm volatile("s_waitcnt vmcnt(" #n ")" ::: "memory")
#define PG8_WAIT_L(n) asm volatile("s_waitcnt lgkmcnt(" #n ")" ::: "memory")
#define PG8_BAR __builtin_amdgcn_s_barrier()
#define PG8_SCHED __builtin_amdgcn_sched_barrier(0)
    Unit cur, nxt; int ui = 0;
    if (!S.next(0, cur)) return;
    f32x4 acc[2][2][4][2];
#pragma unroll
    for (int a = 0; a < 2; ++a)
#pragma unroll
        for (int b = 0; b < 2; ++b)
#pragma unroll
            for (int m = 0; m < 4; ++m)
#pragma unroll
                for (int n = 0; n < 2; ++n) acc[a][b][m][n] = (f32x4){0.f, 0.f, 0.f, 0.f};
    bf16x8 At[4][2], B0[2][2], B1[2][2];
    const char* cA = (const char*)g.A + (size_t)cur.pm * tstepA + (size_t)cur.pn * cstepA; const char* cB = (const char*)g.Bt + (size_t)cur.pn * tstepB;
    PG8_STAGE(PG8_SB(0, 0), cB, voffB); PG8_STAGE(PG8_SB(0, 1), cB + hstepB, voffB); PG8_STAGE(PG8_SA(0, 0), cA, voffA); PG8_STAGE(PG8_SA(0, 1), cA + hstepA, voffA);
    if (wr == 1) PG8_BAR;
    PG8_WAIT_V(2); PG8_BAR;
    PG8_STAGE(PG8_SB(1, 0), cB + kstep, voffB); PG8_STAGE(PG8_SA(1, 0), cA + kstep, voffA); PG8_STAGE(PG8_SB(1, 1), cB + hstepB + kstep, voffB);
    PG8_WAIT_V(6); PG8_BAR;
    for (;;) {
        const bool has_next = S.next(ui + 1, nxt);
        const char* nA = has_next ? (const char*)g.A + (size_t)nxt.pm * tstepA + (size_t)nxt.pn * cstepA : cA; const char* nB = has_next ? (const char*)g.Bt + (size_t)nxt.pn * tstepB : cB;
        for (int t = 0; t < nt; t += 2) {
            const bool last = (t == nt - 2);
            const char* a1 = cA + (size_t)(t + 1) * kstep;
            const char* a2 = last ? nA : cA + (size_t)(t + 2) * kstep; const char* b2 = last ? nB : cB + (size_t)(t + 2) * kstep;
            const char* a3 = a2 + kstep; const char* b3 = b2 + kstep;
            PG8_LDB(B0, 0, 0); PG8_LDB(B1, 0, 1); PG8_SCHED; PG8_LDA(At, 0, 0); PG8_STAGE(PG8_SA(1, 1), a1 + hstepA, voffA);
            PG8_WAIT_V(8); PG8_WAIT_L(0); PG8_BAR; PG8_MMA(0, 0, At, B0); PG8_MMA(0, 1, At, B1); PG8_BAR; PG8_SCHED;
            PG8_LDA(At, 0, 1); PG8_STAGE(PG8_SB(0, 0), b2, voffB); PG8_STAGE(PG8_SB(0, 1), b2 + hstepB, voffB); PG8_STAGE(PG8_SA(0, 0), a2, voffA);
            PG8_WAIT_V(8); PG8_WAIT_L(0); PG8_BAR; PG8_MMA(1, 0, At, B0); PG8_MMA(1, 1, At, B1); PG8_BAR; PG8_SCHED;
            PG8_LDB(B0, 1, 0); PG8_LDB(B1, 1, 1); PG8_SCHED; PG8_LDA(At, 1, 0); PG8_STAGE(PG8_SA(0, 1), a2 + hstepA, voffA);
            PG8_WAIT_V(8); PG8_WAIT_L(0); PG8_BAR; PG8_MMA(0, 0, At, B0); PG8_MMA(0, 1, At, B1); PG8_BAR; PG8_SCHED;
            PG8_LDA(At, 1, 1); PG8_STAGE(PG8_SB(1, 0), b3, voffB); PG8_STAGE(PG8_SB(1, 1), b3 + hstepB, voffB); PG8_STAGE(PG8_SA(1, 0), a3, voffA);
            PG8_WAIT_V(8); PG8_WAIT_L(0); PG8_BAR; PG8_MMA(1, 0, At, B0); PG8_MMA(1, 1, At, B1); PG8_BAR; PG8_SCHED;
        }
        if (wr == 0) PG8_BAR;
        { Unit eu = cur; int efr = fr, efq = fq, elane = lane;
          asm volatile("" : "+s"(eu.pm), "+s"(eu.pn), "+v"(efr), "+v"(efq), "+v"(elane));
          E(acc, eu, wr, wc, efr, efq, el, wid, elane); }
        if (!has_next) break;
#pragma unroll
        for (int a = 0; a < 2; ++a)
#pragma unroll
            for (int b = 0; b < 2; ++b)
#pragma unroll
                for (int m = 0; m < 4; ++m)
#pragma unroll
                    for (int n = 0; n < 2; ++n) acc[a][b][m][n] = (f32x4){0.f, 0.f, 0.f, 0.f};
        cur = nxt; cA = nA; cB = nB; ++ui;
        if (wr == 1) PG8_BAR;
    }
    PG8_WAIT_V(0);
    PG8_BAR;
#undef PG8_SA
#undef PG8_SB
#undef PG8_STAGE
#undef PG8_LDA
#undef PG8_LDB
#undef PG8_MMA
#undef PG8_WAIT_V
#undef PG8_WAIT_L
#undef PG8_BAR
#undef PG8_SCHED
}
}

__device__ __forceinline__ int crow(int r, int hi) { return (r & 3) + 8 * (r >> 2) + 4 * hi; }
__device__ __forceinline__ void attn_phase(LAS unsigned char* lds, const bf16_t* Q, const bf16_t* Kp, const bf16_t* Vp, bf16_t* O, int blk, int G) {
    int tid = threadIdx.x; asm volatile("" : "+v"(tid));
    const int lane = tid & 63, r32 = lane & 31, hi = lane >> 5;
    const int wid = __builtin_amdgcn_readfirstlane(tid >> 6);
    LAS unsigned char* vbuf = lds + wid * 8192;
    LAS bf16_t* obuf = (LAS bf16_t*)(vbuf + 4096);
    LAS unsigned char* vrd = vbuf + ((lane >> 4) & 1) * 32 + (lane & 3) * 8 + (4 * hi + ((lane & 15) >> 2)) * 64;
    LAS bf16x8* vw = (LAS bf16x8*)(vbuf + (lane & 1) * 2048 + (lane >> 1) * 64);
    for (int u = blk; u < (NB * NH * SEQ) / 256; u += G) {
        const int bh = u >> 4, qblk = ((u & 15) << 3) + wid;
        const int b = bh >> 4, h = bh & 15;
        const size_t rowb = (size_t)b * SEQ;
        const bf16_t* qp = Q + (rowb + (size_t)qblk * 32 + r32) * D + h * 64 + hi * 32;
        bf16x8 qf[4];
#pragma unroll
        for (int d0 = 0; d0 < 4; ++d0) qf[d0] = *(const bf16x8*)(qp + d0 * 8);
        const bf16_t* kp = Kp + (rowb + r32) * D + h * 64 + hi * 32;
        const bf16_t* vp = Vp + (rowb + (lane >> 1)) * D + h * 64 + (lane & 1) * 32;
        bf16x8 kf[4], vr[4];
#pragma unroll
        for (int d0 = 0; d0 < 4; ++d0) { kf[d0] = *(const bf16x8*)(kp + (size_t)qblk * 32 * D + d0 * 8); vr[d0] = *(const bf16x8*)(vp + (size_t)qblk * 32 * D + d0 * 8); }
        f32x16 o0, o1;
#pragma unroll
        for (int r = 0; r < 16; ++r) { o0[r] = 0.f; o1[r] = 0.f; }
        float carry = 1.0f;
        for (int kt = qblk; kt >= 0; --kt) {
#pragma unroll
            for (int c = 0; c < 4; ++c) vw[c] = vr[c];
            f32x16 s;
#pragma unroll
            for (int r = 0; r < 16; ++r) s[r] = 0.f;
#pragma unroll
            for (int d0 = 0; d0 < 4; ++d0) s = __builtin_amdgcn_mfma_f32_32x32x16_f16(__builtin_bit_cast(h16x8, kf[d0]), __builtin_bit_cast(h16x8, qf[d0]), s, 0, 0, 0);
            if (kt > 0) {
#pragma unroll
                for (int d0 = 0; d0 < 4; ++d0) { kf[d0] = *(const bf16x8*)(kp + (size_t)(kt - 1) * 32 * D + d0 * 8); vr[d0] = *(const bf16x8*)(vp + (size_t)(kt - 1) * 32 * D + d0 * 8); }
            }
            const bool diag = (kt == qblk);
            float e[16], om[16];
#pragma unroll
            for (int r = 0; r < 16; ++r) {
                float ev = __builtin_amdgcn_exp2f(fminf(s[r], 126.0f));
                if (diag && crow(r, hi) >= r32) ev = 0.f;
                e[r] = ev; om[r] = __builtin_amdgcn_rcpf(1.0f + ev);
            }
            float p32[4], p321[4], gp[4], oth[4];
#pragma unroll
            for (int g = 0; g < 4; ++g) { p32[g] = om[4 * g + 3] * om[4 * g + 2]; p321[g] = p32[g] * om[4 * g + 1]; gp[g] = p321[g] * om[4 * g]; }
#pragma unroll
            for (int g = 0; g < 4; ++g) {
                const unsigned own = __float_as_uint(gp[g]);
                auto rr = __builtin_amdgcn_permlane32_swap(own, own, false, false);
                oth[g] = __uint_as_float(rr[0] != own ? rr[0] : rr[1]);
            }
            float E[4];
            E[3] = carry * (hi ? 1.0f : oth[3]);
            E[2] = E[3] * (gp[3] * (hi ? oth[3] : oth[2]));
            E[1] = E[2] * (gp[2] * (hi ? oth[2] : oth[1]));
            E[0] = E[1] * (gp[1] * (hi ? oth[1] : oth[0]));
            carry = E[0] * (gp[0] * (hi ? oth[0] : 1.0f));
            float a[16];
#pragma unroll
            for (int g = 0; g < 4; ++g) {
                a[4 * g + 3] = e[4 * g + 3] * om[4 * g + 3] * E[g];
                a[4 * g + 2] = e[4 * g + 2] * om[4 * g + 2] * (E[g] * om[4 * g + 3]);
                a[4 * g + 1] = e[4 * g + 1] * om[4 * g + 1] * (E[g] * p32[g]);
                a[4 * g + 0] = e[4 * g + 0] * om[4 * g + 0] * (E[g] * p321[g]);
            }
            const u32x4 pw0 = {cvt_pk_bf16(a[0], a[1]), cvt_pk_bf16(a[2], a[3]), cvt_pk_bf16(a[4], a[5]), cvt_pk_bf16(a[6], a[7])};
            const u32x4 pw1 = {cvt_pk_bf16(a[8], a[9]), cvt_pk_bf16(a[10], a[11]), cvt_pk_bf16(a[12], a[13]), cvt_pk_bf16(a[14], a[15])};
            const bf16x8 pa0 = __builtin_bit_cast(bf16x8, pw0), pa1 = __builtin_bit_cast(bf16x8, pw1);
#pragma unroll
            for (int dblk = 0; dblk < 2; ++dblk) {
                const v4i16_t l0 = __builtin_amdgcn_ds_read_tr16_b64_v4i16((LAS v4i16_t*)(vrd + dblk * 2048));
                const v4i16_t h0 = __builtin_amdgcn_ds_read_tr16_b64_v4i16((LAS v4i16_t*)(vrd + dblk * 2048 + 512));
                const v4i16_t l1 = __builtin_amdgcn_ds_read_tr16_b64_v4i16((LAS v4i16_t*)(vrd + dblk * 2048 + 1024));
                const v4i16_t h1 = __builtin_amdgcn_ds_read_tr16_b64_v4i16((LAS v4i16_t*)(vrd + dblk * 2048 + 1536));
                const bf16x8 vf0 = {l0[0], l0[1], l0[2], l0[3], h0[0], h0[1], h0[2], h0[3]};
                const bf16x8 vf1 = {l1[0], l1[1], l1[2], l1[3], h1[0], h1[1], h1[2], h1[3]};
                if (dblk == 0) { o0 = __builtin_amdgcn_mfma_f32_32x32x16_f16(__builtin_bit_cast(h16x8, pa0), __builtin_bit_cast(h16x8, vf0), o0, 0, 0, 0); o0 = __builtin_amdgcn_mfma_f32_32x32x16_f16(__builtin_bit_cast(h16x8, pa1), __builtin_bit_cast(h16x8, vf1), o0, 0, 0, 0); }
                else           { o1 = __builtin_amdgcn_mfma_f32_32x32x16_f16(__builtin_bit_cast(h16x8, pa0), __builtin_bit_cast(h16x8, vf0), o1, 0, 0, 0); o1 = __builtin_amdgcn_mfma_f32_32x32x16_f16(__builtin_bit_cast(h16x8, pa1), __builtin_bit_cast(h16x8, vf1), o1, 0, 0, 0); }
            }
            if (!__any(carry >= 1.17549435e-38f)) break;
        }
#pragma unroll
        for (int r = 0; r < 16; ++r) { const int orow = crow(r, hi); obuf[orow * 64 + r32] = (bf16_t)f2bf(o0[r]); obuf[orow * 64 + 32 + r32] = (bf16_t)f2bf(o1[r]); }
        bf16_t* Ow = O + (rowb + (size_t)qblk * 32) * D + h * 64;
#pragma unroll
        for (int i = 0; i < 4; ++i) { const int row = i * 8 + (lane >> 3), ch = lane & 7; const u32x4 v = *(const LAS u32x4*)(obuf + row * 64 + ch * 8); *(u32x4*)(Ow + (size_t)row * D + ch * 8) = v; }
    }
}

template <int RMAP, int FOLD>
__device__ __forceinline__ void transpose_item(const float* W, int K, int N, bf16_t* WT, int row_off, const float* gk, const float* bk, float* csp, float* bwp, LAS float* scr, int item, int lane) {
    const int nblk = N / 32, kb = item / nblk, nb = item % nblk, k0 = 64 * kb, n0 = 32 * nb;
#pragma unroll 16
    for (int i = 0; i < 32; ++i) { const int kk = 2 * i + (lane >> 5); scr[kk * 33 + (lane & 31)] = W[(size_t)(k0 + kk) * N + n0 + (lane & 31)]; }
    asm volatile("s_waitcnt lgkmcnt(0)" ::: "memory");
    const int c = lane & 7;
    f32x4 g0 = {1.f, 1.f, 1.f, 1.f}, g1 = {1.f, 1.f, 1.f, 1.f};
    if (FOLD) { g0 = *(const f32x4*)(gk + k0 + 8 * c); g1 = *(const f32x4*)(gk + k0 + 8 * c + 4); }
#pragma unroll
    for (int j = 0; j < 4; ++j) { const int n = (lane >> 3) + 8 * j; const LAS float* s = scr + (8 * c) * 33 + n;
        u32x4 o; o.x = pk2(s[0 * 33] * g0[0], s[1 * 33] * g0[1]); o.y = pk2(s[2 * 33] * g0[2], s[3 * 33] * g0[3]); o.z = pk2(s[4 * 33] * g1[0], s[5 * 33] * g1[1]); o.w = pk2(s[6 * 33] * g1[2], s[7 * 33] * g1[3]);
        const int nn = n0 + n; const int orow = RMAP ? ((nn >> 7) * 256 + (nn & 127) + row_off) : (row_off + nn);
        *(u32x4*)(WT + (size_t)orow * K + k0 + 8 * c) = o; }
    if (FOLD) {
        const int n = lane & 31, kh = lane >> 5; float cs = 0.f, bw = 0.f;
#pragma unroll 8
        for (int i = 0; i < 32; ++i) { const int kk = kh * 32 + i; const float w = scr[kk * 33 + n]; cs += bfround(w * gk[k0 + kk]); bw += w * bk[k0 + kk]; }
        cs += __shfl_xor(cs, 32); bw += __shfl_xor(bw, 32);
        if (kh == 0) { const int nn = n0 + n; const int orow = RMAP ? ((nn >> 7) * 256 + (nn & 127) + row_off) : (row_off + nn); csp[(size_t)kb * VEC_TOT + orow] = cs; bwp[(size_t)kb * VEC_TOT + orow] = bw; }
    }
    asm volatile("s_waitcnt lgkmcnt(0)" ::: "memory");
}
__device__ __forceinline__ void mix_run(const float* x, bf16_t* mix, int run, int lane) {
    const int t0 = (run & 255) * 16; const size_t row0 = (size_t)run * 16;
    const float* xr = x + row0 * D + 4 * lane;
    f32x4 S[4];
#pragma unroll
    for (int j = 0; j < 4; ++j) { const int w = 2 << j; f32x4 s = {0.f, 0.f, 0.f, 0.f};
#pragma unroll
        for (int i = 1; i < w; ++i) if (t0 - i >= 0) s += *(const f32x4*)(xr - (ptrdiff_t)i * D + 256 * j);
        S[j] = s; }
#pragma unroll 4
    for (int tt = 0; tt < 16; ++tt) {
        const int t = t0 + tt;
#pragma unroll
        for (int j = 0; j < 4; ++j) { const int w = 2 << j;
            const f32x4 xv = *(const f32x4*)(xr + (ptrdiff_t)tt * D + 256 * j);
            S[j] += xv;
            const int cnt = (t + 1 < w) ? (t + 1) : w; const float inv = 1.0f / (float)cnt;
            const f32x4 mx = S[j] * inv - xv;
            *(u32x2*)(mix + (row0 + tt) * D + 256 * j + 4 * lane) = (u32x2){pk2(mx[0], mx[1]), pk2(mx[2], mx[3])};
            if (t - w + 1 >= 0) S[j] -= *(const f32x4*)(xr + (ptrdiff_t)(tt - w + 1) * D + 256 * j);
        }
    }
}

#define XB_TMO      128
#define XB_XCNT(j)  (256  + 64 * (j))
#define XB_XSUB(j)  (1280 + 64 * (j))
#define XB_XGEN(j)  (2304 + 64 * (j))
#define XB_TOP      3328
#define XB_TOPGEN   3392
#define XCD_BAR_WORDS 3456
#define XB_SPIN_CAP (1u << 22)
__device__ __forceinline__ unsigned xb_ld(unsigned* p)              { return __hip_atomic_load(p, __ATOMIC_RELAXED, __HIP_MEMORY_SCOPE_AGENT); }
__device__ __forceinline__ unsigned xb_add(unsigned* p, unsigned v) { return __hip_atomic_fetch_add(p, v, __ATOMIC_RELAXED, __HIP_MEMORY_SCOPE_AGENT); }
__device__ __forceinline__ unsigned xb_xcc_id() { return (unsigned)__builtin_amdgcn_s_getreg((3 << 11) | 20) & 0xFu; }
#define XB_SPIN(cond, bar) do { unsigned _sp = 0; while (cond) { __builtin_amdgcn_s_sleep(1); \
    if ((++_sp & 255u) == 0u) { if (xb_ld(&(bar)[XB_TMO])) break; if (_sp > XB_SPIN_CAP) { atomicAdd(&(bar)[XB_TMO], 1u); break; } } } } while (0)
struct XcdBarrier { unsigned* bar; unsigned x; volatile LAS unsigned* st; };
__device__ __forceinline__ XcdBarrier xcd_barrier_post(unsigned* bar, volatile LAS unsigned* st) {
    XcdBarrier b; b.bar = bar; b.x = xb_xcc_id(); b.st = st;
    if (threadIdx.x == 0) (void)xb_add(&bar[XB_XCNT(b.x)], 1u);
    return b;
}
__device__ __forceinline__ void xcd_barrier_complete(unsigned* bar, unsigned x, unsigned& nloc, unsigned& nx) {
    const unsigned G = gridDim.x * gridDim.y * gridDim.z;
    unsigned sum, cnt, mine, sp = 0u;
    for (;;) {
        sum = 0u; cnt = 0u; mine = 0u;
#pragma unroll
        for (unsigned j = 0; j < 16; ++j) { const unsigned c = xb_ld(&bar[XB_XCNT(j)]); sum += c; cnt += (c > 0u) ? 1u : 0u; mine = (j == x) ? c : mine; }
        if (sum == G) break;
        __builtin_amdgcn_s_sleep(1);
        if ((++sp & 255u) == 0u) { if (xb_ld(&bar[XB_TMO])) break; if (sp > XB_SPIN_CAP) { atomicAdd(&bar[XB_TMO], 1u); break; } }
    }
    nloc = mine > 0u ? mine : 1u; nx = cnt > 0u ? cnt : 1u;
}
__device__ __forceinline__ void xcd_barrier(const XcdBarrier& b) {
    asm volatile("s_waitcnt vmcnt(0)" ::: "memory");
    __syncthreads();
    if (threadIdx.x == 0) {
        unsigned* bar = b.bar;
        __builtin_amdgcn_s_waitcnt(0);
        unsigned nloc = b.st[0], nx = b.st[1];
        if (nloc == 0u) { xcd_barrier_complete(bar, b.x, nloc, nx); b.st[0] = nloc; b.st[1] = nx; }
        const unsigned old = xb_add(&bar[XB_XSUB(b.x)], 1u);
        const unsigned gen = old / nloc;
        if (old + 1u == (gen + 1u) * nloc) {
            __builtin_amdgcn_fence(__ATOMIC_RELEASE, "agent");
            asm volatile("s_waitcnt vmcnt(0)" ::: "memory");
            const unsigned og = xb_add(&bar[XB_TOP], 1u);
            const unsigned tg = og / nx;
            if (og + 1u == (tg + 1u) * nx) xb_add(&bar[XB_TOPGEN], 1u);
            else XB_SPIN(xb_ld(&bar[XB_TOPGEN]) == tg, bar);
            __builtin_amdgcn_fence(__ATOMIC_ACQUIRE, "agent");
            xb_add(&bar[XB_XGEN(b.x)], 1u);
            asm volatile("s_waitcnt vmcnt(0)" ::: "memory");
        } else {
            XB_SPIN(xb_ld(&bar[XB_XGEN(b.x)]) == gen, bar);
            __builtin_amdgcn_fence(__ATOMIC_ACQUIRE, "agent");
            asm volatile("s_waitcnt vmcnt(0)" ::: "memory");
        }
    }
    __syncthreads();
}

#ifndef USE_CG_SYNC
#define USE_CG_SYNC 0
#endif

struct Args { const float* in[12]; float* out; unsigned char* ws; };
__global__ void __launch_bounds__(512, 2) fwd_megakernel(Args args) {
    extern __shared__ __attribute__((aligned(16))) unsigned char lds_raw[];
    LAS unsigned char* lds = (LAS unsigned char*)lds_raw;
    LAS unsigned char* el = lds + EPI_OFF;
    volatile LAS unsigned* MISC = (volatile LAS unsigned*)(lds + MISC_OFF);
    const int tid = threadIdx.x, wave = __builtin_amdgcn_readfirstlane(tid >> 6);
    const int G = gridDim.x, blk = blockIdx.x;
    cg::grid_group grid = cg::this_grid();
    unsigned char* ws = args.ws;
    const float* x = args.in[0]; const float* ln_mix_g = args.in[1]; const float* ln_mix_b = args.in[2]; const float* ln_ffn_g = args.in[3]; const float* ln_ffn_b = args.in[4];
    const float* pool_w = args.in[5]; const float* pool_scale = args.in[6]; const float* w_qkv = args.in[7]; const float* w_o = args.in[8];
    const float* w_gate = args.in[9]; const float* w_up = args.in[10]; const float* w_down = args.in[11];
    float* vec = (float*)(ws + WS_VEC);
    float* ST1 = (float*)(ws + WS_ST), *ST2 = (float*)(ws + WS_ST + 1 * MiB), *ST3 = (float*)(ws + WS_ST + 2 * MiB), *ST4 = (float*)(ws + WS_ST + 3 * MiB);
    bf16_t* WPOOL = (bf16_t*)(ws + WS_WPOOL), *WQKV = (bf16_t*)(ws + WS_WQKV), *WO = (bf16_t*)(ws + WS_WO), *WGU0 = (bf16_t*)(ws + WS_WGU0), *WGU1 = (bf16_t*)(ws + WS_WGU1), *WD0 = (bf16_t*)(ws + WS_WD0), *WD1 = (bf16_t*)(ws + WS_WD1);
    bf16_t* XB = (bf16_t*)(ws + WS_XB)  , *HB = (bf16_t*)(ws + WS_H), *QB = (bf16_t*)(ws + WS_Q), *KB = (bf16_t*)(ws + WS_K), *VB = (bf16_t*)(ws + WS_V), *OB = (bf16_t*)(ws + WS_O), *MIX = (bf16_t*)(ws + WS_MIX);

    if (tid < 64) MISC[tid] = 0u;
    __syncthreads();
#if USE_CG_SYNC
#define GRID_BAR() grid.sync()
#else
    if (args.ws == nullptr) grid.sync();
    XcdBarrier bar = xcd_barrier_post((unsigned*)(ws + WS_BAR), MISC + 8);
#define GRID_BAR() xcd_barrier(bar)
#endif

    {
        int lane = tid & 63; asm volatile("" : "+v"(lane));
        const int gw = blk * 8 + wave, NGW = G * 8;
        for (int run = gw; run < M / 16; run += NGW) mix_run(x, MIX, run, lane);
        LAS float* scr = (LAS float*)(lds + wave * 16384);
        float* vp = (float*)(ws + WS_VPART);
        constexpr int I_POOL = 4 * 4 * 8, I_QKV = 16 * 96, I_WO = 16 * 32, I_G = 16 * 88, I_D = 44 * 32;
        constexpr int NITEMS = I_POOL + I_QKV + I_WO + 4 * I_G + 2 * I_D;
        for (int it = gw; it < NITEMS; it += NGW) {
            int r = it;
            if (r < I_POOL) { const int g = r >> 5; transpose_item<0, 0>(pool_w + (size_t)g * 65536, 256, 256, WPOOL, g * 256, nullptr, nullptr, nullptr, nullptr, scr, r & 31, lane); continue; } r -= I_POOL;
            if (r < I_QKV) { transpose_item<0, 1>(w_qkv, D, NQKV, WQKV, 0, ln_ffn_g, ln_ffn_b, vp + V_CS_QKV, vp + V_BW_QKV, scr, r, lane); continue; } r -= I_QKV;
            if (r < I_WO) { transpose_item<0, 0>(w_o, D, D, WO, 0, nullptr, nullptr, nullptr, nullptr, scr, r, lane); continue; } r -= I_WO;
            if (r < I_G) { transpose_item<1, 1>(w_gate, D, FF, WGU0, 0, ln_mix_g, ln_mix_b, vp + V_CS_GU0, vp + V_BW_GU0, scr, r, lane); continue; } r -= I_G;
            if (r < I_G) { transpose_item<1, 1>(w_up, D, FF, WGU0, 128, ln_mix_g, ln_mix_b, vp + V_CS_GU0, vp + V_BW_GU0, scr, r, lane); continue; } r -= I_G;
            if (r < I_G) { transpose_item<1, 1>(w_gate + (size_t)D * FF, D, FF, WGU1, 0, ln_mix_g + D, ln_mix_b + D, vp + V_CS_GU1, vp + V_BW_GU1, scr, r, lane); continue; } r -= I_G;
            if (r < I_G) { transpose_item<1, 1>(w_up + (size_t)D * FF, D, FF, WGU1, 128, ln_mix_g + D, ln_mix_b + D, vp + V_CS_GU1, vp + V_BW_GU1, scr, r, lane); continue; } r -= I_G;
            if (r < I_D) { transpose_item<0, 0>(w_down, FF, D, WD0, 0, nullptr, nullptr, nullptr, nullptr, scr, r, lane); continue; } r -= I_D;
            transpose_item<0, 0>(w_down + (size_t)FF * D, FF, D, WD1, 0, nullptr, nullptr, nullptr, nullptr, scr, r, lane);
        }
    }
    GRID_BAR();
    { int idx = blk * 512 + tid; asm volatile("" : "+v"(idx));
      if (idx < VEC_TOT) { const float* vp = (const float*)(ws + WS_VPART) + idx; float a = 0.f;
#pragma unroll
          for (int k = 0; k < 16; ++k) a += vp[(size_t)k * VEC_TOT];
          vec[idx] = a; } }
    pg8::StaticOrder S;
    { pg8::Gemm g{MIX, WPOOL, M, D, 256, D, 256, 256}; S.init(M, D, G, blk);
      pg8::EpiRes<0> E{x, XB, nullptr, ST1, pool_scale, nullptr};
      pg8::gemm_phase(lds, el, g, S, E); }
    GRID_BAR();
    { pg8::Gemm g{XB, WGU0, M, NGU, D, D, D, 0}; S.init(M, NGU, G, blk);
      pg8::EpiSwiglu E{HB, ST1, vec + V_CS_GU0, vec + V_BW_GU0};
      pg8::gemm_phase(lds, el, g, S, E); }
    GRID_BAR();
    { pg8::Gemm g{HB, WD0, M, D, FF, FF, FF, 0}; S.init(M, D, G, blk);
      pg8::EpiRes<1> E{XB, XB, ST1, ST2, ln_mix_g, ln_mix_b};
      pg8::gemm_phase(lds, el, g, S, E); }
    GRID_BAR();
    { pg8::Gemm g{XB, WQKV, M, NQKV, D, D, D, 0}; S.init(M, NQKV, G, blk);
      pg8::EpiQkv E{QB, (size_t)M * D, ST2, vec + V_CS_QKV, vec + V_BW_QKV};
      pg8::gemm_phase(lds, el, g, S, E); }
    GRID_BAR();
    attn_phase(lds, QB, KB, VB, OB, blk, G);
    GRID_BAR();
    { pg8::Gemm g{OB, WO, M, D, D, D, D, 0}; S.init(M, D, G, blk);
      pg8::EpiRes<1> E{XB, XB, ST2, ST3, ln_ffn_g, ln_ffn_b};
      pg8::gemm_phase(lds, el, g, S, E); }
    GRID_BAR();
    { pg8::Gemm g{XB, WGU1, M, NGU, D, D, D, 0}; S.init(M, NGU, G, blk);
      pg8::EpiSwiglu E{HB, ST3, vec + V_CS_GU1, vec + V_BW_GU1};
      pg8::gemm_phase(lds, el, g, S, E); }
    GRID_BAR();
    { pg8::Gemm g{HB, WD1, M, D, FF, FF, FF, 0}; S.init(M, D, G, blk);
      pg8::EpiRes<1> E{XB, XB, ST3, ST4, ln_mix_g + D, ln_mix_b + D};
      pg8::gemm_phase(lds, el, g, S, E); }
    GRID_BAR();
    {
        int lane = tid & 63; asm volatile("" : "+v"(lane));
        const int gw = blk * 8 + wave, NGW = G * 8;
        const float* gg = ln_ffn_g + D; const float* bb = ln_ffn_b + D;
        f32x4 gv[4], bv[4];
#pragma unroll
        for (int j = 0; j < 4; ++j) { gv[j] = *(const f32x4*)(gg + 256 * j + 4 * lane); bv[j] = *(const f32x4*)(bb + 256 * j + 4 * lane); }
        for (int row = gw; row < M; row += NGW) {
            float mu, rs; pg8::row_stats(ST4, (size_t)row, mu, rs);
            const bf16_t* yr = XB + (size_t)row * D + 4 * lane; float* orow = args.out + (size_t)row * D + 4 * lane;
#pragma unroll
            for (int j = 0; j < 4; ++j) { const f32x4 v = h4_to_f4(*(const u32x2*)(yr + 256 * j)); *(f32x4*)(orow + 256 * j) = (v - mu) * rs * gv[j] + bv[j]; }
        }
    }
}

extern "C" void kernel_launch(void* const* d_in, const int* in_sizes, int n_in, void* d_out, int out_size, void* d_ws, size_t ws_size, hipStream_t stream) {
    static int grid = 0;
    if (grid == 0) {
        if (n_in != 12 || in_sizes[0] != M * D || out_size != M * D || ws_size < WS_END) { fprintf(stderr, "kernel_launch: unexpected shapes (n_in %d, in0 %d, out %d, ws %zu)\n", n_in, n_in > 0 ? in_sizes[0] : -1, out_size, ws_size); grid = -1; return; }
        int dev = 0, cus = 0, per_cu = 0;
        if (hipGetDevice(&dev) != hipSuccess || hipDeviceGetAttribute(&cus, hipDeviceAttributeMultiprocessorCount, dev) != hipSuccess) { grid = -1; return; }
        if (hipFuncSetAttribute((const void*)fwd_megakernel, hipFuncAttributeMaxDynamicSharedMemorySize, LDS_BYTES) != hipSuccess) { fprintf(stderr, "kernel_launch: hipFuncSetAttribute failed\n"); grid = -1; return; }
        if (hipOccupancyMaxActiveBlocksPerMultiprocessor(&per_cu, (const void*)fwd_megakernel, 512, LDS_BYTES) != hipSuccess || per_cu < 1) { fprintf(stderr, "kernel_launch: occupancy query gave %d\n", per_cu); per_cu = 1; }
        (void)hipGetLastError();
        grid = cus * per_cu; if (grid > 256) grid = 256;
    }
    if (grid < 0) return;
    (void)hipMemsetAsync((char*)d_ws + WS_BAR, 0, XCD_BAR_WORDS * 4, stream);
    Args a{};
    for (int i = 0; i < 12; ++i) a.in[i] = (const float*)d_in[i];
    a.out = (float*)d_out; a.ws = (unsigned char*)d_ws;
    void* kargs[] = {&a};
    hipError_t e = hipLaunchCooperativeKernel((const void*)fwd_megakernel, dim3(grid), dim3(512), kargs, LDS_BYTES, stream);
    if (e != hipSuccess) fprintf(stderr, "kernel_launch: cooperative launch failed: %s (grid %d)\n", hipGetErrorString(e), grid);
}
```

```cpp
#include <hip/hip_runtime.h>
#include <hip/hip_cooperative_groups.h>
#include <cstdio>
#include <cstdint>
namespace cg = cooperative_groups;

#define LAS __attribute__((address_space(3)))
typedef unsigned short bf16_t;
typedef short bf16x8 __attribute__((ext_vector_type(8)));
typedef float f32x4 __attribute__((ext_vector_type(4)));
typedef float f32x2 __attribute__((ext_vector_type(2)));
typedef float f32x16 __attribute__((ext_vector_type(16)));
typedef unsigned u32x4 __attribute__((ext_vector_type(4)));
typedef unsigned u32x2 __attribute__((ext_vector_type(2)));
typedef short v4i16_t __attribute__((ext_vector_type(4)));

constexpr int SEQ = 4096, NB = 8, M = NB * SEQ, D = 1024, FF = 2816, NGU = 2 * FF, NQKV = 3 * D, NH = 16;
constexpr float ALPHA = 1.41421356237309515f;
constexpr float LN_EPS = 1e-5f;
constexpr float QSCALE = 0.125f * 1.4426950408889634f;

constexpr size_t MiB = 1u << 20;
constexpr size_t WS_BAR = 0;
constexpr size_t WS_VEC = 1 * MiB;
constexpr size_t WS_ST = 2 * MiB;
constexpr size_t WS_WPOOL = 8 * MiB, WS_WQKV = 9 * MiB, WS_WO = 15 * MiB, WS_WGU0 = 17 * MiB, WS_WGU1 = 28 * MiB, WS_WD0 = 39 * MiB, WS_WD1 = 45 * MiB;
constexpr size_t WS_XB = 64 * MiB;
constexpr size_t WS_R = 128 * MiB;
constexpr size_t WS_H = WS_R, WS_Q = WS_R, WS_K = WS_R + 64 * MiB, WS_V = WS_R + 128 * MiB, WS_O = WS_R + 192 * MiB, WS_MIX = WS_R + 192 * MiB;
constexpr size_t WS_END = WS_R + 256 * MiB;
constexpr int V_CS_QKV = 0, V_BW_QKV = 3072, V_CS_GU0 = 6144, V_BW_GU0 = V_CS_GU0 + NGU, V_CS_GU1 = V_BW_GU0 + NGU, V_BW_GU1 = V_CS_GU1 + NGU;
constexpr int VEC_TOT = V_BW_GU1 + NGU;
constexpr size_t WS_VPART = 6 * MiB;

constexpr int RING_BYTES = 131072, EPI_OFF = RING_BYTES, EPI_BYTES = 8192, MISC_OFF = EPI_OFF + EPI_BYTES, LDS_BYTES = MISC_OFF + 256;

typedef _Float16 h16x8 __attribute__((ext_vector_type(8)));
typedef _Float16 h16x4 __attribute__((ext_vector_type(4)));
typedef _Float16 h16x2 __attribute__((ext_vector_type(2)));
__device__ __forceinline__ unsigned f2bf(float f) { return (unsigned)__builtin_bit_cast(unsigned short, (_Float16)f); }
__device__ __forceinline__ unsigned pk2(float lo, float hi) { const h16x2 p = {(_Float16)lo, (_Float16)hi}; return __builtin_bit_cast(unsigned, p); }
__device__ __forceinline__ float bfround(float f) { return (float)(_Float16)f; }
__device__ __forceinline__ unsigned cvt_pk_bf16(float lo, float hi) { return pk2(lo, hi); }
__device__ __forceinline__ f32x4 h4_to_f4(u32x2 raw) { return __builtin_convertvector(__builtin_bit_cast(h16x4, raw), f32x4); }
__device__ __forceinline__ u32x2 f4_to_h4(f32x4 v) { return __builtin_bit_cast(u32x2, __builtin_convertvector(v, h16x4)); }

namespace pg8 {
constexpr int BM = 256, BK = 64, HALF = 128, HTB = HALF * BK * 2, STAGE_BYTES = 8 * HTB, NXCD = 8, WGM = 8;
__host__ __device__ __forceinline__ int lds_byte(int r, int c) { const int st = (r >> 4) * 2 + (c >> 5), rr = r & 15, cc = c & 31, ob = rr * 64 + cc * 2; return st * 1024 + (ob ^ (((ob >> 9) & 1) << 5)); }
__host__ __device__ __forceinline__ void stage_rc(int b, int& R, int& C) { const int st = b / 1024, sb = b % 1024, swz = sb ^ (((sb >> 9) & 1) << 5); R = (st >> 1) * 16 + swz / 64; C = (st & 1) * 32 + (swz % 64) / 2; }
__host__ __device__ __forceinline__ int perm32(int rho) { const int n = rho >> 4, i = rho & 15; return 8 * (i >> 2) + 4 * n + (i & 3); }

struct Unit { int pm, pn; };
struct Gemm { const bf16_t* A; const bf16_t* Bt; int M, N, K, lda, ldb, acol; };

struct StaticOrder {
    int nM, nN, nwg, G, c;
    __device__ void init(int M_, int N_, int G_, int c_) { nM = M_ / BM; nN = N_ / BM; nwg = nM * nN; G = G_; c = c_; }
    __device__ bool next(int i, Unit& u) const {
        const long L = (long)i * G + c; if (L >= nwg) return false;
        int wgid = (int)L; { const int q = nwg / NXCD, r = nwg % NXCD, xcd = wgid % NXCD, off = wgid / NXCD; wgid = (xcd < r ? xcd * (q + 1) : r * (q + 1) + (xcd - r) * q) + off; }
        const int nig = WGM * nN, gid = wgid / nig, fm = gid * WGM, gsz = (nM - fm) < WGM ? (nM - fm) : WGM;
        u.pm = fm + ((wgid % nig) % gsz); u.pn = (wgid % nig) / gsz; return true;
    }
};

__device__ __forceinline__ void row_stats(const float* st, size_t row, float& mu, float& rstd) {
    const f32x4* p = (const f32x4*)(st + row * 8);
    const f32x4 a = p[0], b = p[1];
    const float mean = ((a.x + a.z) + (b.x + b.z)) * 0.25f;
    const float d0 = a.x - mean, d1 = a.z - mean, d2 = b.x - mean, d3 = b.z - mean;
    const float m2 = (a.y + a.w) + (b.y + b.w) + 256.0f * ((d0 * d0 + d1 * d1) + (d2 * d2 + d3 * d3));
    mu = mean; rstd = 1.0f / sqrtf(m2 * (1.0f / 1024.0f) + LN_EPS);
}


struct EpiSwiglu {
    static constexpr bool PERM = true;
    bf16_t* Hout; const float* st; const float* cs; const float* bw;
    __device__ __forceinline__ void operator()(f32x4 (&acc)[2][2][4][2], const Unit& u, int wr, int wc, int fr, int fq, LAS unsigned char*, int, int) const {
        const int tc = u.pn * BM + wc * 32 + 8 * fq, hc = u.pn * HALF + wc * 32 + 8 * fq;
        f32x4 csv[2][2], bwv[2][2];
#pragma unroll
        for (int bj = 0; bj < 2; ++bj)
#pragma unroll
            for (int n = 0; n < 2; ++n) { csv[bj][n] = *(const f32x4*)(cs + tc + bj * HALF + 4 * n); bwv[bj][n] = *(const f32x4*)(bw + tc + bj * HALF + 4 * n); }
#pragma unroll
        for (int ai = 0; ai < 2; ++ai)
#pragma unroll
            for (int m = 0; m < 4; ++m) {
                const size_t row = (size_t)u.pm * BM + ai * HALF + wr * 64 + m * 16 + fr;
                float mu, rs; row_stats(st, row, mu, rs);
                unsigned w[4];
#pragma unroll
                for (int n = 0; n < 2; ++n) {
                    const f32x4 g = (acc[ai][0][m][n] - mu * csv[0][n]) * rs + bwv[0][n];
                    const f32x4 up = (acc[ai][1][m][n] - mu * csv[1][n]) * rs + bwv[1][n];
                    float h[4];
#pragma unroll
                    for (int e = 0; e < 4; ++e) { const float ex = __builtin_amdgcn_exp2f(g[e] * -1.4426950408889634f); h[e] = g[e] * __builtin_amdgcn_rcpf(1.0f + ex) * up[e]; }
                    w[2 * n] = cvt_pk_bf16(h[0], h[1]); w[2 * n + 1] = cvt_pk_bf16(h[2], h[3]);
                }
                *(u32x4*)(Hout + row * FF + hc) = (u32x4){w[0], w[1], w[2], w[3]};
                if (m & 1) asm volatile("" ::: "memory");
            }
    }
};
struct EpiQkv {
    static constexpr bool PERM = true;
    bf16_t* O; size_t stride; const float* st; const float* cs; const float* bw;
    __device__ __forceinline__ void operator()(f32x4 (&acc)[2][2][4][2], const Unit& u, int wr, int wc, int fr, int fq, LAS unsigned char*, int, int) const {
        const int tc = u.pn * BM + wc * 32 + 8 * fq; const int t = u.pn >> 2; const int oc = (u.pn & 3) * BM + wc * 32 + 8 * fq;
        bf16_t* base = O + (size_t)t * stride; const float sc = (t == 0) ? QSCALE : 1.0f;
        f32x4 csv[2][2], bwv[2][2];
#pragma unroll
        for (int bj = 0; bj < 2; ++bj)
#pragma unroll
            for (int n = 0; n < 2; ++n) { csv[bj][n] = *(const f32x4*)(cs + tc + bj * HALF + 4 * n); bwv[bj][n] = *(const f32x4*)(bw + tc + bj * HALF + 4 * n); }
#pragma unroll
        for (int ai = 0; ai < 2; ++ai)
#pragma unroll
            for (int m = 0; m < 4; ++m) {
                const size_t row = (size_t)u.pm * BM + ai * HALF + wr * 64 + m * 16 + fr;
                float mu, rs; row_stats(st, row, mu, rs);
#pragma unroll
                for (int bj = 0; bj < 2; ++bj) {
                    const f32x4 v0 = ((acc[ai][bj][m][0] - mu * csv[bj][0]) * rs + bwv[bj][0]) * sc;
                    const f32x4 v1 = ((acc[ai][bj][m][1] - mu * csv[bj][1]) * rs + bwv[bj][1]) * sc;
                    *(u32x4*)(base + row * D + oc + bj * HALF) = (u32x4){cvt_pk_bf16(v0[0], v0[1]), cvt_pk_bf16(v0[2], v0[3]), cvt_pk_bf16(v1[0], v1[1]), cvt_pk_bf16(v1[2], v1[3])};
                }
                if (m & 1) asm volatile("" ::: "memory");
            }
    }
};
template <int MODE> struct EpiRes {
    static constexpr bool PERM = false;
    const void* base; bf16_t* y; const float* stp; float* sto; const float* v0; const float* v1;
    __device__ __forceinline__ void operator()(f32x4 (&acc)[2][2][4][2], const Unit& u, int wr, int wc, int fr, int fq, LAS unsigned char* el, int wid, int lane) const {
        LAS f32x2* P = (LAS f32x2*)el;
        const int col0 = u.pn * BM + wc * 32 + 4 * fq;
        f32x4 ga[2][2], gb[2][2];
#pragma unroll
        for (int bj = 0; bj < 2; ++bj)
#pragma unroll
            for (int n = 0; n < 2; ++n) { const int c = col0 + bj * HALF + n * 16; ga[bj][n] = *(const f32x4*)(v0 + c); if (MODE == 1) gb[bj][n] = *(const f32x4*)(v1 + c) * ALPHA; else gb[bj][n] = (f32x4){0.f, 0.f, 0.f, 0.f}; }
#pragma unroll
        for (int ai = 0; ai < 2; ++ai)
#pragma unroll
            for (int m = 0; m < 4; ++m) {
                const int rl = ai * HALF + wr * 64 + m * 16 + fr; const size_t row = (size_t)u.pm * BM + rl; const size_t off = row * D + col0;
                float mu = 0.f, rs = 0.f; if (MODE == 1) { row_stats(stp, row, mu, rs); rs *= ALPHA; }
                float s = 0.f;
#pragma unroll
                for (int bj = 0; bj < 2; ++bj)
#pragma unroll
                    for (int n = 0; n < 2; ++n) {
                        f32x4 v;
                        if (MODE == 0) { const f32x4 bs = *(const f32x4*)((const float*)base + off + bj * HALF + n * 16); v = bs * ALPHA + acc[ai][bj][m][n] * ga[bj][n]; }
                        else { const f32x4 bs = h4_to_f4(*(const u32x2*)((const bf16_t*)base + off + bj * HALF + n * 16)); v = (bs - mu) * rs * ga[bj][n] + gb[bj][n] + acc[ai][bj][m][n]; }
                        const u32x2 hv = f4_to_h4(v);
                        *(u32x2*)(y + off + bj * HALF + n * 16) = hv;
                        v = h4_to_f4(hv);
                        acc[ai][bj][m][n] = v; s += (v[0] + v[1]) + (v[2] + v[3]);
                    }
                s += __shfl_xor(s, 16); s += __shfl_xor(s, 32);
                const float mw = s * (1.0f / 64.0f); float q = 0.f;
#pragma unroll
                for (int bj = 0; bj < 2; ++bj)
#pragma unroll
                    for (int n = 0; n < 2; ++n) { const f32x4 d = acc[ai][bj][m][n] - mw; q += (d[0] * d[0] + d[1] * d[1]) + (d[2] * d[2] + d[3] * d[3]); }
                q += __shfl_xor(q, 16); q += __shfl_xor(q, 32);
                if (fq == 0) P[rl * 4 + wc] = (f32x2){mw, q};
                asm volatile("" ::: "memory");
            }
        asm volatile("s_waitcnt lgkmcnt(0)" ::: "memory"); __builtin_amdgcn_s_barrier(); asm volatile("" ::: "memory");
        if (lane < 32) {
            const int row = wid * 32 + lane;
            const f32x2 a = P[row * 4 + 0], b = P[row * 4 + 1], c = P[row * 4 + 2], d = P[row * 4 + 3];
            const float mt = ((a.x + b.x) + (c.x + d.x)) * 0.25f;
            const float da = a.x - mt, db = b.x - mt, dc = c.x - mt, dd = d.x - mt;
            const float m2 = (a.y + b.y) + (c.y + d.y) + 64.0f * ((da * da + db * db) + (dc * dc + dd * dd));
            *(f32x2*)(sto + ((size_t)u.pm * BM + row) * 8 + u.pn * 2) = (f32x2){mt, m2};
        }
        asm volatile("s_waitcnt lgkmcnt(0)" ::: "memory"); __builtin_amdgcn_s_barrier(); asm volatile("" ::: "memory");
    }
};

template <class Epi, class Sched>
__device__ __forceinline__ void gemm_phase(LAS unsigned char* lds, LAS unsigned char* el, const Gemm g, const Sched& S, const Epi& E) {
    int tid = threadIdx.x; asm volatile("" : "+v"(tid));
    const int wid = __builtin_amdgcn_readfirstlane(tid >> 6), lane = tid & 63, wr = wid >> 2, wc = wid & 3, fr = lane & 15, fq = lane >> 4;
    int K = g.K; asm volatile("" : "+s"(K));
    const int nt = K / BK;
    unsigned voffA[2], voffB[2];
#pragma unroll
    for (int i = 0; i < 2; ++i) { int R, C; stage_rc(tid * 16 + i * 8192, R, C); const int Rb = Epi::PERM ? ((R & ~31) + perm32(R & 31)) : R;
        voffA[i] = (unsigned)(R * g.lda + C) * 2u; voffB[i] = (unsigned)(Rb * g.ldb + C) * 2u; }
    const size_t kstep = (size_t)(BK * 2);
    const size_t hstepA = (size_t)HALF * g.lda * 2, hstepB = (size_t)HALF * g.ldb * 2, tstepA = 2 * hstepA, tstepB = 2 * hstepB, cstepA = (size_t)g.acol * 2;
    const unsigned ldsw = (unsigned)wid * 1024u;
    const int aoff = lds_byte(wr * 64 + fr, fq * 8), boff = lds_byte(wc * 32 + fr, fq * 8);
#define PG8_SA(b, h) (((b) * 2 + (h)) * HTB)
#define PG8_SB(b, h) ((4 + (b) * 2 + (h)) * HTB)
#define PG8_STAGE(bufoff, gbase, voff) do { _Pragma("unroll") for (int _i = 0; _i < 2; ++_i) \
        __builtin_amdgcn_global_load_lds((const unsigned*)((const char*)(gbase) + (voff)[_i]), (LAS unsigned*)(lds + (bufoff) + ldsw + _i * 8192), 16, 0, 0); } while (0)
#define PG8_LDA(dst, b, h) do { _Pragma("unroll") for (int m = 0; m < 4; ++m) _Pragma("unroll") for (int k = 0; k < 2; ++k) dst[m][k] = *(const LAS bf16x8*)(lds + PG8_SA(b, h) + aoff + m * 2048 + k * 1024); } while (0)
#define PG8_LDB(dst, b, h) do { _Pragma("unroll") for (int n = 0; n < 2; ++n) _Pragma("unroll") for (int k = 0; k < 2; ++k) dst[n][k] = *(const LAS bf16x8*)(lds + PG8_SB(b, h) + boff + n * 2048 + k * 1024); } while (0)
#define PG8_MMA(ai, bj, At, Bt) do { __builtin_amdgcn_s_setprio(1); _Pragma("unroll") for (int m = 0; m < 4; ++m) _Pragma("unroll") for (int n = 0; n < 2; ++n) _Pragma("unroll") for (int k = 0; k < 2; ++k) \
        asm volatile("v_mfma_f32_16x16x32_f16 %0, %1, %2, %0" : "+v"(acc[ai][bj][m][n]) : "v"(Bt[n][k]), "v"(At[m][k])); __builtin_amdgcn_s_setprio(0); } while (0)
#define PG8_WAIT_V(n) asm volatile("s_waitcnt vmcnt(" #n ")" ::: "memory")
#define PG8_WAIT_L(n) asm volatile("s_waitcnt lgkmcnt(" #n ")" ::: "memory")
#define PG8_BAR __builtin_amdgcn_s_barrier()
#define PG8_SCHED __builtin_amdgcn_sched_barrier(0)
    Unit cur, nxt; int ui = 0;
    if (!S.next(0, cur)) return;
    f32x4 acc[2][2][4][2];
#pragma unroll
    for (int a = 0; a < 2; ++a)
#pragma unroll
        for (int b = 0; b < 2; ++b)
#pragma unroll
            for (int m = 0; m < 4; ++m)
#pragma unroll
                for (int n = 0; n < 2; ++n) acc[a][b][m][n] = (f32x4){0.f, 0.f, 0.f, 0.f};
    bf16x8 At[4][2], B0[2][2], B1[2][2];
    const char* cA = (const char*)g.A + (size_t)cur.pm * tstepA + (size_t)cur.pn * cstepA; const char* cB = (const char*)g.Bt + (size_t)cur.pn * tstepB;
    PG8_STAGE(PG8_SB(0, 0), cB, voffB); PG8_STAGE(PG8_SB(0, 1), cB + hstepB, voffB); PG8_STAGE(PG8_SA(0, 0), cA, voffA); PG8_STAGE(PG8_SA(0, 1), cA + hstepA, voffA);
    if (wr == 1) PG8_BAR;
    PG8_WAIT_V(2); PG8_BAR;
    PG8_STAGE(PG8_SB(1, 0), cB + kstep, voffB); PG8_STAGE(PG8_SA(1, 0), cA + kstep, voffA); PG8_STAGE(PG8_SB(1, 1), cB + hstepB + kstep, voffB);
    PG8_WAIT_V(6); PG8_BAR;
    for (;;) {
        const bool has_next = S.next(ui + 1, nxt);
        const char* nA = has_next ? (const char*)g.A + (size_t)nxt.pm * tstepA + (size_t)nxt.pn * cstepA : cA; const char* nB = has_next ? (const char*)g.Bt + (size_t)nxt.pn * tstepB : cB;
        for (int t = 0; t < nt; t += 2) {
            const bool last = (t == nt - 2);
            const char* a1 = cA + (size_t)(t + 1) * kstep;
            const char* a2 = last ? nA : cA + (size_t)(t + 2) * kstep; const char* b2 = last ? nB : cB + (size_t)(t + 2) * kstep;
            const char* a3 = a2 + kstep; const char* b3 = b2 + kstep;
            PG8_LDB(B0, 0, 0); PG8_LDB(B1, 0, 1); PG8_SCHED; PG8_LDA(At, 0, 0); PG8_STAGE(PG8_SA(1, 1), a1 + hstepA, voffA);
            PG8_WAIT_V(8); PG8_WAIT_L(0); PG8_BAR; PG8_MMA(0, 0, At, B0); PG8_MMA(0, 1, At, B1); PG8_BAR; PG8_SCHED;
            PG8_LDA(At, 0, 1); PG8_STAGE(PG8_SB(0, 0), b2, voffB); PG8_STAGE(PG8_SB(0, 1), b2 + hstepB, voffB); PG8_STAGE(PG8_SA(0, 0), a2, voffA);
            PG8_WAIT_V(8); PG8_WAIT_L(0); PG8_BAR; PG8_MMA(1, 0, At, B0); PG8_MMA(1, 1, At, B1); PG8_BAR; PG8_SCHED;
            PG8_LDB(B0, 1, 0); PG8_LDB(B1, 1, 1); PG8_SCHED; PG8_LDA(At, 1, 0); PG8_STAGE(PG8_SA(0, 1), a2 + hstepA, voffA);
            PG8_WAIT_V(8); PG8_WAIT_L(0); PG8_BAR; PG8_MMA(0, 0, At, B0); PG8_MMA(0, 1, At, B1); PG8_BAR; PG8_SCHED;
            PG8_LDA(At, 1, 1); PG8_STAGE(PG8_SB(1, 0), b3, voffB); PG8_STAGE(PG8_SB(1, 1), b3 + hstepB, voffB); PG8_STAGE(PG8_SA(1, 0), a3, voffA);
            PG8_WAIT_V(8); PG8_WAIT_L(0); PG8_BAR; PG8_MMA(1, 0, At, B0); PG8_MMA(1, 1, At, B1); PG8_BAR; PG8_SCHED;
        }
        if (wr == 0) PG8_BAR;
        { Unit eu = cur; int efr = fr, efq = fq, elane = lane;
          asm volatile("" : "+s"(eu.pm), "+s"(eu.pn), "+v"(efr), "+v"(efq), "+v"(elane));
          asm volatile("s_nop 15\n\ts_nop 7" ::: "memory");
          E(acc, eu, wr, wc, efr, efq, el, wid, elane); }
        if (!has_next) break;
#pragma unroll
        for (int a = 0; a < 2; ++a)
#pragma unroll
            for (int b = 0; b < 2; ++b)
#pragma unroll
                for (int m = 0; m < 4; ++m)
#pragma unroll
                    for (int n = 0; n < 2; ++n) acc[a][b][m][n] = (f32x4){0.f, 0.f, 0.f, 0.f};
        cur = nxt; cA = nA; cB = nB; ++ui;
        if (wr == 1) PG8_BAR;
    }
    PG8_WAIT_V(0);
    PG8_BAR;
#undef PG8_SA
#undef PG8_SB
#undef PG8_STAGE
#undef PG8_LDA
#undef PG8_LDB
#undef PG8_MMA
#undef PG8_WAIT_V
#undef PG8_WAIT_L
#undef PG8_BAR
#undef PG8_SCHED
}
}

__device__ __forceinline__ int crow(int r, int hi) { return (r & 3) + 8 * (r >> 2) + 4 * hi; }
__device__ __forceinline__ void mfma_s_chain(f32x16& s, const bf16x8 (&kf)[4], const bf16x8 (&qf)[4]) {
    asm volatile("s_nop 1\n\t"
                 "v_mfma_f32_32x32x16_f16 %0, %1, %5, 0\n\t"
                 "v_mfma_f32_32x32x16_f16 %0, %2, %6, %0\n\t"
                 "v_mfma_f32_32x32x16_f16 %0, %3, %7, %0\n\t"
                 "v_mfma_f32_32x32x16_f16 %0, %4, %8, %0\n\t"
                 "s_nop 15\n\ts_nop 7"
                 : "=&v"(s) : "v"(kf[0]), "v"(kf[1]), "v"(kf[2]), "v"(kf[3]), "v"(qf[0]), "v"(qf[1]), "v"(qf[2]), "v"(qf[3]));
}
__device__ __forceinline__ void mfma_pv(f32x16& o0, f32x16& o1, bf16x8 pa0, bf16x8 pa1, bf16x8 vf0, bf16x8 vf1, bf16x8 vf2, bf16x8 vf3) {
    asm volatile("s_nop 1\n\t"
                 "v_mfma_f32_32x32x16_f16 %0, %2, %4, %0\n\t"
                 "v_mfma_f32_32x32x16_f16 %0, %3, %5, %0\n\t"
                 "v_mfma_f32_32x32x16_f16 %1, %2, %6, %1\n\t"
                 "v_mfma_f32_32x32x16_f16 %1, %3, %7, %1"
                 : "+v"(o0), "+v"(o1) : "v"(pa0), "v"(pa1), "v"(vf0), "v"(vf1), "v"(vf2), "v"(vf3));
}
__device__ __forceinline__ void mfma_pad(f32x16& c) { asm volatile("s_nop 15\n\ts_nop 7" : "+v"(c)); }
__device__ __forceinline__ void attn_phase(LAS unsigned char* lds, const bf16_t* Q, const bf16_t* Kp, const bf16_t* Vp, bf16_t* O, int blk, int G) {
    int tid = threadIdx.x; asm volatile("" : "+v"(tid));
    const int lane = tid & 63, r32 = lane & 31, hi = lane >> 5;
    const int wid = __builtin_amdgcn_readfirstlane(tid >> 6);
    LAS unsigned char* vbuf = lds + wid * 8192;
    LAS bf16_t* obuf = (LAS bf16_t*)(vbuf + 4096);
    LAS unsigned char* vrd = vbuf + ((lane >> 4) & 1) * 32 + (lane & 3) * 8 + (4 * hi + ((lane & 15) >> 2)) * 64;
    LAS bf16x8* vw = (LAS bf16x8*)(vbuf + (lane & 1) * 2048 + (lane >> 1) * 64);
    for (int u = blk; u < (NB * NH * SEQ) / 256; u += G) {
        const int bh = u >> 4, qblk = ((u & 15) << 3) + wid;
        const int b = bh >> 4, h = bh & 15;
        const size_t rowb = (size_t)b * SEQ;
        const bf16_t* qp = Q + (rowb + (size_t)qblk * 32 + r32) * D + h * 64 + hi * 32;
        bf16x8 qf[4];
#pragma unroll
        for (int d0 = 0; d0 < 4; ++d0) qf[d0] = *(const bf16x8*)(qp + d0 * 8);
        const bf16_t* kp = Kp + (rowb + r32) * D + h * 64 + hi * 32;
        const bf16_t* vp = Vp + (rowb + (lane >> 1)) * D + h * 64 + (lane & 1) * 32;
        bf16x8 kf[4], vr[4];
#pragma unroll
        for (int d0 = 0; d0 < 4; ++d0) { kf[d0] = *(const bf16x8*)(kp + (size_t)qblk * 32 * D + d0 * 8); vr[d0] = *(const bf16x8*)(vp + (size_t)qblk * 32 * D + d0 * 8); }
        f32x16 o0, o1;
#pragma unroll
        for (int r = 0; r < 16; ++r) { o0[r] = 0.f; o1[r] = 0.f; }
        float carry = 1.0f;
        for (int kt = qblk; kt >= 0; --kt) {
#pragma unroll
            for (int c = 0; c < 4; ++c) vw[c] = vr[c];
            f32x16 s;
            mfma_s_chain(s, kf, qf);
            if (kt > 0) {
#pragma unroll
                for (int d0 = 0; d0 < 4; ++d0) { kf[d0] = *(const bf16x8*)(kp + (size_t)(kt - 1) * 32 * D + d0 * 8); vr[d0] = *(const bf16x8*)(vp + (size_t)(kt - 1) * 32 * D + d0 * 8); }
            }
            const bool diag = (kt == qblk);
            float e[16], om[16];
#pragma unroll
            for (int r = 0; r < 16; ++r) {
                float ev = __builtin_amdgcn_exp2f(fminf(s[r], 126.0f));
                if (diag && crow(r, hi) >= r32) ev = 0.f;
                e[r] = ev; om[r] = __builtin_amdgcn_rcpf(1.0f + ev);
            }
            float p32[4], p321[4], gp[4], oth[4];
#pragma unroll
            for (int g = 0; g < 4; ++g) { p32[g] = om[4 * g + 3] * om[4 * g + 2]; p321[g] = p32[g] * om[4 * g + 1]; gp[g] = p321[g] * om[4 * g]; }
#pragma unroll
            for (int g = 0; g < 4; ++g) {
                const unsigned own = __float_as_uint(gp[g]);
                auto rr = __builtin_amdgcn_permlane32_swap(own, own, false, false);
                oth[g] = __uint_as_float(rr[0] != own ? rr[0] : rr[1]);
            }
            float E[4];
            E[3] = carry * (hi ? 1.0f : oth[3]);
            E[2] = E[3] * (gp[3] * (hi ? oth[3] : oth[2]));
            E[1] = E[2] * (gp[2] * (hi ? oth[2] : oth[1]));
            E[0] = E[1] * (gp[1] * (hi ? oth[1] : oth[0]));
            carry = E[0] * (gp[0] * (hi ? oth[0] : 1.0f));
            float a[16];
#pragma unroll
            for (int g = 0; g < 4; ++g) {
                a[4 * g + 3] = e[4 * g + 3] * om[4 * g + 3] * E[g];
                a[4 * g + 2] = e[4 * g + 2] * om[4 * g + 2] * (E[g] * om[4 * g + 3]);
                a[4 * g + 1] = e[4 * g + 1] * om[4 * g + 1] * (E[g] * p32[g]);
                a[4 * g + 0] = e[4 * g + 0] * om[4 * g + 0] * (E[g] * p321[g]);
            }
            const u32x4 pw0 = {cvt_pk_bf16(a[0], a[1]), cvt_pk_bf16(a[2], a[3]), cvt_pk_bf16(a[4], a[5]), cvt_pk_bf16(a[6], a[7])};
            const u32x4 pw1 = {cvt_pk_bf16(a[8], a[9]), cvt_pk_bf16(a[10], a[11]), cvt_pk_bf16(a[12], a[13]), cvt_pk_bf16(a[14], a[15])};
            const bf16x8 pa0 = __builtin_bit_cast(bf16x8, pw0), pa1 = __builtin_bit_cast(bf16x8, pw1);
            {
                const v4i16_t l0 = __builtin_amdgcn_ds_read_tr16_b64_v4i16((LAS v4i16_t*)(vrd));
                const v4i16_t h0 = __builtin_amdgcn_ds_read_tr16_b64_v4i16((LAS v4i16_t*)(vrd + 512));
                const v4i16_t l1 = __builtin_amdgcn_ds_read_tr16_b64_v4i16((LAS v4i16_t*)(vrd + 1024));
                const v4i16_t h1 = __builtin_amdgcn_ds_read_tr16_b64_v4i16((LAS v4i16_t*)(vrd + 1536));
                const v4i16_t l2 = __builtin_amdgcn_ds_read_tr16_b64_v4i16((LAS v4i16_t*)(vrd + 2048));
                const v4i16_t h2 = __builtin_amdgcn_ds_read_tr16_b64_v4i16((LAS v4i16_t*)(vrd + 2048 + 512));
                const v4i16_t l3 = __builtin_amdgcn_ds_read_tr16_b64_v4i16((LAS v4i16_t*)(vrd + 2048 + 1024));
                const v4i16_t h3 = __builtin_amdgcn_ds_read_tr16_b64_v4i16((LAS v4i16_t*)(vrd + 2048 + 1536));
                const bf16x8 vf0 = {l0[0], l0[1], l0[2], l0[3], h0[0], h0[1], h0[2], h0[3]};
                const bf16x8 vf1 = {l1[0], l1[1], l1[2], l1[3], h1[0], h1[1], h1[2], h1[3]};
                const bf16x8 vf2 = {l2[0], l2[1], l2[2], l2[3], h2[0], h2[1], h2[2], h2[3]};
                const bf16x8 vf3 = {l3[0], l3[1], l3[2], l3[3], h3[0], h3[1], h3[2], h3[3]};
                mfma_pv(o0, o1, pa0, pa1, vf0, vf1, vf2, vf3);
            }
            if (!__any(carry >= 1.17549435e-38f)) break;
        }
        mfma_pad(o0); mfma_pad(o1);
#pragma unroll
        for (int r = 0; r < 16; ++r) { const int orow = crow(r, hi); obuf[orow * 64 + r32] = (bf16_t)f2bf(o0[r]); obuf[orow * 64 + 32 + r32] = (bf16_t)f2bf(o1[r]); }
        bf16_t* Ow = O + (rowb + (size_t)qblk * 32) * D + h * 64;
#pragma unroll
        for (int i = 0; i < 4; ++i) { const int row = i * 8 + (lane >> 3), ch = lane & 7; const u32x4 v = *(const LAS u32x4*)(obuf + row * 64 + ch * 8); *(u32x4*)(Ow + (size_t)row * D + ch * 8) = v; }
    }
}

template <int RMAP, int FOLD>
__device__ __forceinline__ void transpose_item(const float* W, int K, int N, bf16_t* WT, int row_off, const float* gk, const float* bk, float* csp, float* bwp, LAS float* scr, int item, int lane) {
    const int nblk = N / 32, kb = item / nblk, nb = item % nblk, k0 = 64 * kb, n0 = 32 * nb;
#pragma unroll 16
    for (int i = 0; i < 32; ++i) { const int kk = 2 * i + (lane >> 5); scr[kk * 33 + (lane & 31)] = W[(size_t)(k0 + kk) * N + n0 + (lane & 31)]; }
    asm volatile("s_waitcnt lgkmcnt(0)" ::: "memory");
    const int c = lane & 7;
    f32x4 g0 = {1.f, 1.f, 1.f, 1.f}, g1 = {1.f, 1.f, 1.f, 1.f};
    if (FOLD) { g0 = *(const f32x4*)(gk + k0 + 8 * c); g1 = *(const f32x4*)(gk + k0 + 8 * c + 4); }
#pragma unroll
    for (int j = 0; j < 4; ++j) { const int n = (lane >> 3) + 8 * j; const LAS float* s = scr + (8 * c) * 33 + n;
        u32x4 o; o.x = pk2(s[0 * 33] * g0[0], s[1 * 33] * g0[1]); o.y = pk2(s[2 * 33] * g0[2], s[3 * 33] * g0[3]); o.z = pk2(s[4 * 33] * g1[0], s[5 * 33] * g1[1]); o.w = pk2(s[6 * 33] * g1[2], s[7 * 33] * g1[3]);
        const int nn = n0 + n; const int orow = RMAP ? ((nn >> 7) * 256 + (nn & 127) + row_off) : (row_off + nn);
        *(u32x4*)(WT + (size_t)orow * K + k0 + 8 * c) = o; }
    if (FOLD) {
        const int n = lane & 31, kh = lane >> 5; float cs = 0.f, bw = 0.f;
#pragma unroll 8
        for (int i = 0; i < 32; ++i) { const int kk = kh * 32 + i; const float w = scr[kk * 33 + n]; cs += bfround(w * gk[k0 + kk]); bw += w * bk[k0 + kk]; }
        cs += __shfl_xor(cs, 32); bw += __shfl_xor(bw, 32);
        if (kh == 0) { const int nn = n0 + n; const int orow = RMAP ? ((nn >> 7) * 256 + (nn & 127) + row_off) : (row_off + nn); csp[(size_t)kb * VEC_TOT + orow] = cs; bwp[(size_t)kb * VEC_TOT + orow] = bw; }
    }
    asm volatile("s_waitcnt lgkmcnt(0)" ::: "memory");
}
__device__ __forceinline__ void mix_run(const float* x, bf16_t* mix, int run, int lane) {
    const int t0 = (run & 255) * 16; const size_t row0 = (size_t)run * 16;
    const float* xr = x + row0 * D + 4 * lane;
    f32x4 S[4];
#pragma unroll
    for (int j = 0; j < 4; ++j) { const int w = 2 << j; f32x4 s = {0.f, 0.f, 0.f, 0.f};
#pragma unroll
        for (int i = 1; i < w; ++i) if (t0 - i >= 0) s += *(const f32x4*)(xr - (ptrdiff_t)i * D + 256 * j);
        S[j] = s; }
#pragma unroll 4
    for (int tt = 0; tt < 16; ++tt) {
        const int t = t0 + tt;
#pragma unroll
        for (int j = 0; j < 4; ++j) { const int w = 2 << j;
            const f32x4 xv = *(const f32x4*)(xr + (ptrdiff_t)tt * D + 256 * j);
            S[j] += xv;
            const int cnt = (t + 1 < w) ? (t + 1) : w; const float inv = 1.0f / (float)cnt;
            const f32x4 mx = S[j] * inv - xv;
            *(u32x2*)(mix + (row0 + tt) * D + 256 * j + 4 * lane) = (u32x2){pk2(mx[0], mx[1]), pk2(mx[2], mx[3])};
            if (t - w + 1 >= 0) S[j] -= *(const f32x4*)(xr + (ptrdiff_t)(tt - w + 1) * D + 256 * j);
        }
    }
}

#define XB_TMO      128
#define XB_XCNT(j)  (256  + 64 * (j))
#define XB_XSUB(j)  (1280 + 64 * (j))
#define XB_XGEN(j)  (2304 + 64 * (j))
#define XB_TOP      3328
#define XB_TOPGEN   3392
#define XCD_BAR_WORDS 3456
#define XB_SPIN_CAP (1u << 22)
__device__ __forceinline__ unsigned xb_ld(unsigned* p)              { return __hip_atomic_load(p, __ATOMIC_RELAXED, __HIP_MEMORY_SCOPE_AGENT); }
__device__ __forceinline__ unsigned xb_add(unsigned* p, unsigned v) { return __hip_atomic_fetch_add(p, v, __ATOMIC_RELAXED, __HIP_MEMORY_SCOPE_AGENT); }
__device__ __forceinline__ unsigned xb_xcc_id() { return (unsigned)__builtin_amdgcn_s_getreg((3 << 11) | 20) & 0xFu; }
#define XB_SPIN(cond, bar) do { unsigned _sp = 0; while (cond) { __builtin_amdgcn_s_sleep(1); \
    if ((++_sp & 255u) == 0u) { if (xb_ld(&(bar)[XB_TMO])) break; if (_sp > XB_SPIN_CAP) { atomicAdd(&(bar)[XB_TMO], 1u); break; } } } } while (0)
struct XcdBarrier { unsigned* bar; unsigned x; volatile LAS unsigned* st; };
__device__ __forceinline__ XcdBarrier xcd_barrier_post(unsigned* bar, volatile LAS unsigned* st) {
    XcdBarrier b; b.bar = bar; b.x = xb_xcc_id(); b.st = st;
    if (threadIdx.x == 0) (void)xb_add(&bar[XB_XCNT(b.x)], 1u);
    return b;
}
__device__ __forceinline__ void xcd_barrier_complete(unsigned* bar, unsigned x, unsigned& nloc, unsigned& nx) {
    const unsigned G = gridDim.x * gridDim.y * gridDim.z;
    unsigned sum, cnt, mine, sp = 0u;
    for (;;) {
        sum = 0u; cnt = 0u; mine = 0u;
#pragma unroll
        for (unsigned j = 0; j < 16; ++j) { const unsigned c = xb_ld(&bar[XB_XCNT(j)]); sum += c; cnt += (c > 0u) ? 1u : 0u; mine = (j == x) ? c : mine; }
        if (sum == G) break;
        __builtin_amdgcn_s_sleep(1);
        if ((++sp & 255u) == 0u) { if (xb_ld(&bar[XB_TMO])) break; if (sp > XB_SPIN_CAP) { atomicAdd(&bar[XB_TMO], 1u); break; } }
    }
    nloc = mine > 0u ? mine : 1u; nx = cnt > 0u ? cnt : 1u;
}
__device__ __forceinline__ void xcd_barrier(const XcdBarrier& b) {
    asm volatile("s_waitcnt vmcnt(0)" ::: "memory");
    __syncthreads();
    if (threadIdx.x == 0) {
        unsigned* bar = b.bar;
        __builtin_amdgcn_s_waitcnt(0);
        unsigned nloc = b.st[0], nx = b.st[1];
        if (nloc == 0u) { xcd_barrier_complete(bar, b.x, nloc, nx); b.st[0] = nloc; b.st[1] = nx; }
        const unsigned old = xb_add(&bar[XB_XSUB(b.x)], 1u);
        const unsigned gen = old / nloc;
        if (old + 1u == (gen + 1u) * nloc) {
            __builtin_amdgcn_fence(__ATOMIC_RELEASE, "agent");
            asm volatile("s_waitcnt vmcnt(0)" ::: "memory");
            const unsigned og = xb_add(&bar[XB_TOP], 1u);
            const unsigned tg = og / nx;
            if (og + 1u == (tg + 1u) * nx) xb_add(&bar[XB_TOPGEN], 1u);
            else XB_SPIN(xb_ld(&bar[XB_TOPGEN]) == tg, bar);
            __builtin_amdgcn_fence(__ATOMIC_ACQUIRE, "agent");
            xb_add(&bar[XB_XGEN(b.x)], 1u);
            asm volatile("s_waitcnt vmcnt(0)" ::: "memory");
        } else {
            XB_SPIN(xb_ld(&bar[XB_XGEN(b.x)]) == gen, bar);
            __builtin_amdgcn_fence(__ATOMIC_ACQUIRE, "agent");
            asm volatile("s_waitcnt vmcnt(0)" ::: "memory");
        }
    }
    __syncthreads();
}

#ifndef USE_CG_SYNC
#define USE_CG_SYNC 0
#endif

struct Args { const float* in[12]; float* out; unsigned char* ws; };
__global__ void __launch_bounds__(512, 2) fwd_megakernel(Args args) {
    extern __shared__ __attribute__((aligned(16))) unsigned char lds_raw[];
    LAS unsigned char* lds = (LAS unsigned char*)lds_raw;
    LAS unsigned char* el = lds + EPI_OFF;
    volatile LAS unsigned* MISC = (volatile LAS unsigned*)(lds + MISC_OFF);
    const int tid = threadIdx.x, wave = __builtin_amdgcn_readfirstlane(tid >> 6);
    const int G = gridDim.x, blk = blockIdx.x;
    cg::grid_group grid = cg::this_grid();
    unsigned char* ws = args.ws;
    const float* x = args.in[0]; const float* ln_mix_g = args.in[1]; const float* ln_mix_b = args.in[2]; const float* ln_ffn_g = args.in[3]; const float* ln_ffn_b = args.in[4];
    const float* pool_w = args.in[5]; const float* pool_scale = args.in[6]; const float* w_qkv = args.in[7]; const float* w_o = args.in[8];
    const float* w_gate = args.in[9]; const float* w_up = args.in[10]; const float* w_down = args.in[11];
    float* vec = (float*)(ws + WS_VEC);
    float* ST1 = (float*)(ws + WS_ST), *ST2 = (float*)(ws + WS_ST + 1 * MiB), *ST3 = (float*)(ws + WS_ST + 2 * MiB), *ST4 = (float*)(ws + WS_ST + 3 * MiB);
    bf16_t* WPOOL = (bf16_t*)(ws + WS_WPOOL), *WQKV = (bf16_t*)(ws + WS_WQKV), *WO = (bf16_t*)(ws + WS_WO), *WGU0 = (bf16_t*)(ws + WS_WGU0), *WGU1 = (bf16_t*)(ws + WS_WGU1), *WD0 = (bf16_t*)(ws + WS_WD0), *WD1 = (bf16_t*)(ws + WS_WD1);
    bf16_t* XB = (bf16_t*)(ws + WS_XB)  , *HB = (bf16_t*)(ws + WS_H), *QB = (bf16_t*)(ws + WS_Q), *KB = (bf16_t*)(ws + WS_K), *VB = (bf16_t*)(ws + WS_V), *OB = (bf16_t*)(ws + WS_O), *MIX = (bf16_t*)(ws + WS_MIX);

    if (tid < 64) MISC[tid] = 0u;
    __syncthreads();
#if USE_CG_SYNC
#define GRID_BAR() grid.sync()
#else
    if (args.ws == nullptr) grid.sync();
    XcdBarrier bar = xcd_barrier_post((unsigned*)(ws + WS_BAR), MISC + 8);
#define GRID_BAR() xcd_barrier(bar)
#endif

    {
        int lane = tid & 63; asm volatile("" : "+v"(lane));
        const int gw = blk * 8 + wave, NGW = G * 8;
        for (int run = gw; run < M / 16; run += NGW) mix_run(x, MIX, run, lane);
        LAS float* scr = (LAS float*)(lds + wave * 16384);
        float* vp = (float*)(ws + WS_VPART);
        constexpr int I_POOL = 4 * 4 * 8, I_QKV = 16 * 96, I_WO = 16 * 32, I_G = 16 * 88, I_D = 44 * 32;
        constexpr int NITEMS = I_POOL + I_QKV + I_WO + 4 * I_G + 2 * I_D;
        for (int it = gw; it < NITEMS; it += NGW) {
            int r = it;
            if (r < I_POOL) { const int g = r >> 5; transpose_item<0, 0>(pool_w + (size_t)g * 65536, 256, 256, WPOOL, g * 256, nullptr, nullptr, nullptr, nullptr, scr, r & 31, lane); continue; } r -= I_POOL;
            if (r < I_QKV) { transpose_item<0, 1>(w_qkv, D, NQKV, WQKV, 0, ln_ffn_g, ln_ffn_b, vp + V_CS_QKV, vp + V_BW_QKV, scr, r, lane); continue; } r -= I_QKV;
            if (r < I_WO) { transpose_item<0, 0>(w_o, D, D, WO, 0, nullptr, nullptr, nullptr, nullptr, scr, r, lane); continue; } r -= I_WO;
            if (r < I_G) { transpose_item<1, 1>(w_gate, D, FF, WGU0, 0, ln_mix_g, ln_mix_b, vp + V_CS_GU0, vp + V_BW_GU0, scr, r, lane); continue; } r -= I_G;
            if (r < I_G) { transpose_item<1, 1>(w_up, D, FF, WGU0, 128, ln_mix_g, ln_mix_b, vp + V_CS_GU0, vp + V_BW_GU0, scr, r, lane); continue; } r -= I_G;
            if (r < I_G) { transpose_item<1, 1>(w_gate + (size_t)D * FF, D, FF, WGU1, 0, ln_mix_g + D, ln_mix_b + D, vp + V_CS_GU1, vp + V_BW_GU1, scr, r, lane); continue; } r -= I_G;
            if (r < I_G) { transpose_item<1, 1>(w_up + (size_t)D * FF, D, FF, WGU1, 128, ln_mix_g + D, ln_mix_b + D, vp + V_CS_GU1, vp + V_BW_GU1, scr, r, lane); continue; } r -= I_G;
            if (r < I_D) { transpose_item<0, 0>(w_down, FF, D, WD0, 0, nullptr, nullptr, nullptr, nullptr, scr, r, lane); continue; } r -= I_D;
            transpose_item<0, 0>(w_down + (size_t)FF * D, FF, D, WD1, 0, nullptr, nullptr, nullptr, nullptr, scr, r, lane);
        }
    }
    GRID_BAR();
    { int idx = blk * 512 + tid; asm volatile("" : "+v"(idx));
      if (idx < VEC_TOT) { const float* vp = (const float*)(ws + WS_VPART) + idx; float a = 0.f;
#pragma unroll
          for (int k = 0; k < 16; ++k) a += vp[(size_t)k * VEC_TOT];
          vec[idx] = a; } }
    pg8::StaticOrder S;
    { pg8::Gemm g{MIX, WPOOL, M, D, 256, D, 256, 256}; S.init(M, D, G, blk);
      pg8::EpiRes<0> E{x, XB, nullptr, ST1, pool_scale, nullptr};
      pg8::gemm_phase(lds, el, g, S, E); }
    GRID_BAR();
    { pg8::Gemm g{XB, WGU0, M, NGU, D, D, D, 0}; S.init(M, NGU, G, blk);
      pg8::EpiSwiglu E{HB, ST1, vec + V_CS_GU0, vec + V_BW_GU0};
      pg8::gemm_phase(lds, el, g, S, E); }
    GRID_BAR();
    { pg8::Gemm g{HB, WD0, M, D, FF, FF, FF, 0}; S.init(M, D, G, blk);
      pg8::EpiRes<1> E{XB, XB, ST1, ST2, ln_mix_g, ln_mix_b};
      pg8::gemm_phase(lds, el, g, S, E); }
    GRID_BAR();
    { pg8::Gemm g{XB, WQKV, M, NQKV, D, D, D, 0}; S.init(M, NQKV, G, blk);
      pg8::EpiQkv E{QB, (size_t)M * D, ST2, vec + V_CS_QKV, vec + V_BW_QKV};
      pg8::gemm_phase(lds, el, g, S, E); }
    GRID_BAR();
    attn_phase(lds, QB, KB, VB, OB, blk, G);
    GRID_BAR();
    { pg8::Gemm g{OB, WO, M, D, D, D, D, 0}; S.init(M, D, G, blk);
      pg8::EpiRes<1> E{XB, XB, ST2, ST3, ln_ffn_g, ln_ffn_b};
      pg8::gemm_phase(lds, el, g, S, E); }
    GRID_BAR();
    { pg8::Gemm g{XB, WGU1, M, NGU, D, D, D, 0}; S.init(M, NGU, G, blk);
      pg8::EpiSwiglu E{HB, ST3, vec + V_CS_GU1, vec + V_BW_GU1};
      pg8::gemm_phase(lds, el, g, S, E); }
    GRID_BAR();
    { pg8::Gemm g{HB, WD1, M, D, FF, FF, FF, 0}; S.init(M, D, G, blk);
      pg8::EpiRes<1> E{XB, XB, ST3, ST4, ln_mix_g + D, ln_mix_b + D};
      pg8::gemm_phase(lds, el, g, S, E); }
    GRID_BAR();
    {
        int lane = tid & 63; asm volatile("" : "+v"(lane));
        const int gw = blk * 8 + wave, NGW = G * 8;
        const float* gg = ln_ffn_g + D; const float* bb = ln_ffn_b + D;
        f32x4 gv[4], bv[4];
#pragma unroll
        for (int j = 0; j < 4; ++j) { gv[j] = *(const f32x4*)(gg + 256 * j + 4 * lane); bv[j] = *(const f32x4*)(bb + 256 * j + 4 * lane); }
        for (int row = gw; row < M; row += NGW) {
            float mu, rs; pg8::row_stats(ST4, (size_t)row, mu, rs);
            const bf16_t* yr = XB + (size_t)row * D + 4 * lane; float* orow = args.out + (size_t)row * D + 4 * lane;
#pragma unroll
            for (int j = 0; j < 4; ++j) { const f32x4 v = h4_to_f4(*(const u32x2*)(yr + 256 * j)); *(f32x4*)(orow + 256 * j) = (v - mu) * rs * gv[j] + bv[j]; }
        }
    }
}

extern "C" void kernel_launch(void* const* d_in, const int* in_sizes, int n_in, void* d_out, int out_size, void* d_ws, size_t ws_size, hipStream_t stream) {
    static int grid = 0;
    if (grid == 0) {
        if (n_in != 12 || in_sizes[0] != M * D || out_size != M * D || ws_size < WS_END) { fprintf(stderr, "kernel_launch: unexpected shapes (n_in %d, in0 %d, out %d, ws %zu)\n", n_in, n_in > 0 ? in_sizes[0] : -1, out_size, ws_size); grid = -1; return; }
        int dev = 0, cus = 0, per_cu = 0;
        if (hipGetDevice(&dev) != hipSuccess || hipDeviceGetAttribute(&cus, hipDeviceAttributeMultiprocessorCount, dev) != hipSuccess) { grid = -1; return; }
        if (hipFuncSetAttribute((const void*)fwd_megakernel, hipFuncAttributeMaxDynamicSharedMemorySize, LDS_BYTES) != hipSuccess) { fprintf(stderr, "kernel_launch: hipFuncSetAttribute failed\n"); grid = -1; return; }
        if (hipOccupancyMaxActiveBlocksPerMultiprocessor(&per_cu, (const void*)fwd_megakernel, 512, LDS_BYTES) != hipSuccess || per_cu < 1) { fprintf(stderr, "kernel_launch: occupancy query gave %d\n", per_cu); per_cu = 1; }
        (void)hipGetLastError();
        grid = cus * per_cu; if (grid > 256) grid = 256;
    }
    if (grid < 0) return;
    (void)hipMemsetAsync((char*)d_ws + WS_BAR, 0, XCD_BAR_WORDS * 4, stream);
    Args a{};
    for (int i = 0; i < 12; ++i) a.in[i] = (const float*)d_in[i];
    a.out = (float*)d_out; a.ws = (unsigned char*)d_ws;
    void* kargs[] = {&a};
    hipError_t e = hipLaunchCooperativeKernel((const void*)fwd_megakernel, dim3(grid), dim3(512), kargs, LDS_BYTES, stream);
    if (e != hipSuccess) fprintf(stderr, "kernel_launch: cooperative launch failed: %s (grid %d)\n", hipGetErrorString(e), grid);
}
```
